# Optimizing an MI355X kernel written in HIP

```python
import jax, jax.numpy as jnp
from jax import lax
import numpy as np

D_MODEL = 1024
BATCH = 2
SEQ = 16384
DEPTH = 2

D_CONV = 1024
CONV_WIDTH = 3
N_HEADS = 8
HEAD_DIM = 128
D_ATT = N_HEADS * HEAD_DIM
N_IDX_HEADS = 8
IDX_DIM = 64
MAX_TOPK = 256
Q_BLOCK = 128
N_MEM = 256
N_MEM_HEADS = 4
MEM_HEAD_DIM = 256
D_MEM = N_MEM_HEADS * MEM_HEAD_DIM
N_BRANCH = 3
D_FF = 3584
N_EXPERTS = 8
TOP_K = 2
MOE_BLOCK = 256
N_DENSE = (DEPTH + 1) // 2
N_MOE = DEPTH // 2
ROPE_THETA = 10000.0
EPS = 1e-6

SPLITS = [D_CONV, D_CONV, D_CONV, D_ATT, D_ATT, D_ATT, N_IDX_HEADS * IDX_DIM, IDX_DIM, N_IDX_HEADS, D_MEM, D_MODEL, D_MODEL, D_MODEL]
D_IN = 3 * D_CONV + 3 * D_ATT + N_IDX_HEADS * IDX_DIM + IDX_DIM + N_IDX_HEADS + D_MEM + N_BRANCH * D_MODEL

kernel_name = 'hybrid_gatedconv_dsa_memxattn_moe'


def rms_norm(x, g):
    xf = x.astype(jnp.float32)
    y = xf * lax.rsqrt(jnp.mean(xf * xf, axis=-1, keepdims=True) + EPS)
    return (y * g.astype(jnp.float32)).astype(x.dtype)


def rope_tables(seq, dim):
    inv = 1.0 / (ROPE_THETA ** (jnp.arange(0, dim, 2, dtype=jnp.float32) / dim))
    ang = jnp.arange(seq, dtype=jnp.float32)[:, None] * inv[None, :]
    return jnp.cos(ang), jnp.sin(ang)


def apply_rope(x, cos, sin):
    c = cos[None, :, None, :].astype(x.dtype)
    s = sin[None, :, None, :].astype(x.dtype)
    x1, x2 = jnp.split(x, 2, axis=-1)
    return jnp.concatenate([x1 * c - x2 * s, x2 * c + x1 * s], axis=-1)


def causal_dwconv(u, w):
    return lax.conv_general_dilated(u, w[:, None, :], window_strides=(1,), padding=[(CONV_WIDTH - 1, 0)], dimension_numbers=('NWC', 'WIO', 'NWC'), feature_group_count=u.shape[-1])


def swiglu(x, w_gate, w_up, w_down):
    return jnp.matmul(jax.nn.silu(jnp.matmul(x, w_gate)) * jnp.matmul(x, w_up), w_down)


def dsa_attention(q, k, v, qi, ki, wi, topk):
    b, s, h, dh = q.shape
    n_blk = s // Q_BLOCK
    key_pos = jnp.arange(s)
    scale = dh ** -0.5

    def block(i):
        start = i * Q_BLOCK
        qb = lax.dynamic_slice_in_dim(q, start, Q_BLOCK, axis=1)
        qib = lax.dynamic_slice_in_dim(qi, start, Q_BLOCK, axis=1)
        wib = lax.dynamic_slice_in_dim(wi, start, Q_BLOCK, axis=1)
        q_pos = start + jnp.arange(Q_BLOCK)
        rel = jax.nn.relu(jnp.einsum('bqhd,bsd->bqhs', qib, ki).astype(jnp.float32))
        score = jnp.einsum('bqhs,bqh->bqs', rel, wib.astype(jnp.float32))
        causal = key_pos[None, :] <= q_pos[:, None]
        score = jnp.where(causal[None], score, -jnp.inf)
        _, idx = lax.top_k(score, topk)
        k_sel = jax.vmap(lambda kk, ii: kk[ii])(k, idx)
        v_sel = jax.vmap(lambda vv, ii: vv[ii])(v, idx)
        logits = jnp.einsum('bqhd,bqkhd->bhqk', qb, k_sel).astype(jnp.float32) * scale
        valid = idx <= q_pos[None, :, None]
        logits = jnp.where(valid[:, None], logits, -jnp.inf)
        p = jax.nn.softmax(logits, axis=-1).astype(v.dtype)
        return jnp.einsum('bhqk,bqkhd->bqhd', p, v_sel)

    out = lax.map(block, jnp.arange(n_blk))
    return jnp.moveaxis(out, 0, 1).reshape(b, s, h * dh)


def memory_cross_attention(qm, mem, mem_norm, w_mem_kv, mq_norm, mk_norm):
    b, s, _ = qm.shape
    m = rms_norm(mem, mem_norm)
    mk, mv = jnp.split(jnp.matmul(m, w_mem_kv), 2, axis=-1)
    n_mem = mem.shape[1]
    mk = rms_norm(mk.reshape(b, n_mem, N_MEM_HEADS, MEM_HEAD_DIM), mk_norm)
    mv = mv.reshape(b, n_mem, N_MEM_HEADS, MEM_HEAD_DIM)
    qh = rms_norm(qm.reshape(b, s, N_MEM_HEADS, MEM_HEAD_DIM), mq_norm)
    logits = jnp.einsum('bshd,bmhd->bhsm', qh, mk).astype(jnp.float32) * (MEM_HEAD_DIM ** -0.5)
    p = jax.nn.softmax(logits, axis=-1).astype(mv.dtype)
    return jnp.einsum('bhsm,bmhd->bshd', p, mv).reshape(b, s, D_MEM)


def mixer_block(x, mem, attn_norm, w_in, conv_w, q_norm, k_norm, mem_norm, w_mem_kv, mq_norm, mk_norm, w_br_conv, w_br_attn, w_br_mem, w_out, rope_att, rope_idx, topk):
    b, s, _ = x.shape
    h = rms_norm(x, attn_norm)
    offsets = [int(o) for o in np.cumsum(SPLITS)[:-1]]
    (cb, cc, cu, q, k, v, qi, ki, wi, qm, g_conv, g_att, g_mem) = jnp.split(jnp.matmul(h, w_in), offsets, axis=-1)

    conv_out = cb * causal_dwconv(cc * cu, conv_w)

    cos, sin = rope_att
    cos_i, sin_i = rope_idx
    q = apply_rope(rms_norm(q.reshape(b, s, N_HEADS, HEAD_DIM), q_norm), cos, sin)
    k = apply_rope(rms_norm(k.reshape(b, s, N_HEADS, HEAD_DIM), k_norm), cos, sin)
    v = v.reshape(b, s, N_HEADS, HEAD_DIM)
    qi = apply_rope(qi.reshape(b, s, N_IDX_HEADS, IDX_DIM), cos_i, sin_i)
    ki = apply_rope(ki.reshape(b, s, 1, IDX_DIM), cos_i, sin_i)[:, :, 0]
    wi = wi * ((N_IDX_HEADS * IDX_DIM) ** -0.5)
    att_out = dsa_attention(q, k, v, qi, ki, wi, topk)

    mem_out = memory_cross_attention(qm, mem, mem_norm, w_mem_kv, mq_norm, mk_norm)

    merged = (jax.nn.sigmoid(g_conv) * jnp.matmul(conv_out, w_br_conv)
              + jax.nn.sigmoid(g_att) * jnp.matmul(att_out, w_br_attn)
              + jax.nn.sigmoid(g_mem) * jnp.matmul(mem_out, w_br_mem))
    return jnp.matmul(merged, w_out)


def moe_swiglu(h, router, w_gate, w_up, w_down):
    b, s, d = h.shape
    n_tok = b * s
    n_asg = n_tok * TOP_K
    t = h.reshape(n_tok, d)
    logits = jnp.matmul(t, router).astype(jnp.float32)
    top_val, top_idx = lax.top_k(logits, TOP_K)
    gate = jax.nn.softmax(top_val, axis=-1)
    eid = top_idx.reshape(-1)
    tok = jnp.repeat(jnp.arange(n_tok, dtype=jnp.int32), TOP_K)
    gw = gate.reshape(-1)
    order = jnp.argsort(eid)
    eid_s, tok_s, gw_s = eid[order], tok[order], gw[order]
    counts = jnp.bincount(eid, length=N_EXPERTS)
    padded = (counts + MOE_BLOCK - 1) // MOE_BLOCK * MOE_BLOCK
    pad_end = jnp.cumsum(padded)
    pad_start = pad_end - padded
    seg_start = jnp.cumsum(counts) - counts
    dest = pad_start[eid_s] + jnp.arange(n_asg) - seg_start[eid_s]
    n_blk = -(-n_asg // MOE_BLOCK) + N_EXPERTS
    cap = n_blk * MOE_BLOCK
    slot_tok = jnp.zeros((cap,), jnp.int32).at[dest].set(tok_s)
    slot_w = jnp.zeros((cap,), jnp.float32).at[dest].set(gw_s)
    blk_exp = jnp.minimum(jnp.searchsorted(pad_end, jnp.arange(n_blk) * MOE_BLOCK, side='right'), N_EXPERTS - 1)

    def run(args):
        e, toks, w = args
        y = swiglu(t[toks], w_gate[e], w_up[e], w_down[e])
        return (y.astype(jnp.float32) * w[:, None]).astype(t.dtype)

    ys = lax.map(run, (blk_exp, slot_tok.reshape(n_blk, MOE_BLOCK), slot_w.reshape(n_blk, MOE_BLOCK)))
    out = jnp.zeros_like(t).at[slot_tok].add(ys.reshape(cap, d))
    return out.reshape(b, s, d)


def setup_inputs(seed: int = 0) -> dict:
    key = jax.random.key(seed)
    ks = jax.random.split(key, 32)

    def nrm(k, shape, fan_in):
        return jax.random.normal(k, shape, jnp.float32) * (fan_in ** -0.5)

    def gain(k, shape):
        return 1.0 + 0.02 * jax.random.normal(k, shape, jnp.float32)

    return {
        'x': jax.random.normal(ks[0], (BATCH, SEQ, D_MODEL), jnp.float32),
        'mem': jax.random.normal(ks[1], (BATCH, N_MEM, D_MODEL), jnp.float32),
        'attn_norm': gain(ks[2], (DEPTH, D_MODEL)),
        'w_in': nrm(ks[3], (DEPTH, D_MODEL, D_IN), D_MODEL),
        'conv_w': nrm(ks[4], (DEPTH, CONV_WIDTH, D_CONV), CONV_WIDTH),
        'q_norm': gain(ks[5], (DEPTH, HEAD_DIM)),
        'k_norm': gain(ks[6], (DEPTH, HEAD_DIM)),
        'mem_norm': gain(ks[7], (DEPTH, D_MODEL)),
        'w_mem_kv': nrm(ks[8], (DEPTH, D_MODEL, 2 * D_MEM), D_MODEL),
        'mq_norm': gain(ks[9], (DEPTH, MEM_HEAD_DIM)),
        'mk_norm': gain(ks[10], (DEPTH, MEM_HEAD_DIM)),
        'w_br_conv': nrm(ks[11], (DEPTH, D_CONV, D_MODEL), D_CONV),
        'w_br_attn': nrm(ks[12], (DEPTH, D_ATT, D_MODEL), D_ATT),
        'w_br_mem': nrm(ks[13], (DEPTH, D_MEM, D_MODEL), D_MEM),
        'w_out': nrm(ks[14], (DEPTH, D_MODEL, D_MODEL), D_MODEL),
        'ffn_norm': gain(ks[15], (DEPTH, D_MODEL)),
        'ff_gate': nrm(ks[16], (N_DENSE, D_MODEL, D_FF), D_MODEL),
        'ff_up': nrm(ks[17], (N_DENSE, D_MODEL, D_FF), D_MODEL),
        'ff_down': nrm(ks[18], (N_DENSE, D_FF, D_MODEL), D_FF),
        'router': nrm(ks[19], (N_MOE, D_MODEL, N_EXPERTS), D_MODEL),
        'ex_gate': nrm(ks[20], (N_MOE, N_EXPERTS, D_MODEL, D_FF), D_MODEL),
        'ex_up': nrm(ks[21], (N_MOE, N_EXPERTS, D_MODEL, D_FF), D_MODEL),
        'ex_down': nrm(ks[22], (N_MOE, N_EXPERTS, D_FF, D_MODEL), D_FF),
    }


def reference(x, mem, attn_norm, w_in, conv_w, q_norm, k_norm, mem_norm, w_mem_kv, mq_norm, mk_norm, w_br_conv, w_br_attn, w_br_mem, w_out, ffn_norm, ff_gate, ff_up, ff_down, router, ex_gate, ex_up, ex_down):
    s = x.shape[1]
    topk = min(MAX_TOPK, s // 4)
    rope_att = rope_tables(s, HEAD_DIM)
    rope_idx = rope_tables(s, IDX_DIM)
    for l in range(DEPTH):
        x = x + mixer_block(x, mem, attn_norm[l], w_in[l], conv_w[l], q_norm[l], k_norm[l], mem_norm[l], w_mem_kv[l], mq_norm[l], mk_norm[l], w_br_conv[l], w_br_attn[l], w_br_mem[l], w_out[l], rope_att, rope_idx, topk)
        h = rms_norm(x, ffn_norm[l])
        j = l // 2
        if l % 2 == 0:
            x = x + swiglu(h, ff_gate[j], ff_up[j], ff_down[j])
        else:
            x = x + moe_swiglu(h, router[j], ex_gate[j], ex_up[j], ex_down[j])
    return x
```

```cpp
#include <hip/hip_runtime.h>
#include <cstdio>
#include <cstdint>

#ifndef MK_N_LAUNCHES
#define MK_N_LAUNCHES 1
#endif

#define GAS __attribute__((address_space(1)))
#define LAS __attribute__((address_space(3)))
typedef unsigned short bf16;
typedef unsigned v4u __attribute__((ext_vector_type(4)));
typedef unsigned v2u __attribute__((ext_vector_type(2)));
typedef float f32x4 __attribute__((ext_vector_type(4)));
typedef float f32x16 __attribute__((ext_vector_type(16)));
typedef short bf16x8 __attribute__((ext_vector_type(8)));
typedef GAS unsigned gu32;
#define RLX_AGENT __ATOMIC_RELAXED, __HIP_MEMORY_SCOPE_AGENT
#define LDS_WAIT() asm volatile("s_waitcnt lgkmcnt(0)" ::: "memory")
#define VM_WAIT() asm volatile("s_waitcnt vmcnt(0)" ::: "memory")

constexpr int DM = 1024, NBATCH = 2, SEQ = 16384, TOK = NBATCH * SEQ, DEPTH = 2;
constexpr int DIN = 10824;
constexpr int LDB = 11008;
constexpr int C_CB = 0, C_CC = 1024, C_CU = 2048, C_Q = 3072, C_K = 4096, C_V = 5120, C_QI = 6144, C_KI = 6656, C_WI = 6720, C_QM = 6912, C_GC = 7936, C_GA = 8960, C_GM = 9984;
constexpr int NH = 8, HD = 128, NIH = 8, IDIM = 64, TOPK = 256;
constexpr int NMEM = 256, NMH = 4, MHD = 256;
constexpr int DFF = 3584, NEXP = 8;
constexpr float EPS = 1e-6f;
constexpr float LOG2E = 1.4426950408889634f;
constexpr int GRID = 256;
constexpr int NWAVES = 8, NTHREADS = 512;
constexpr int MOE_MAXP = 136;

constexpr size_t MiB = 1u << 20;
constexpr size_t WS_CTL = 0, CTL_ZERO_BYTES = 64 * 1024;
constexpr size_t WS_ROPEA = 1 * MiB;
constexpr size_t WS_ROPEI = 9 * MiB;
constexpr size_t WS_TAB = 13 * MiB;
constexpr size_t WS_MEMN = 15 * MiB;
constexpr size_t WS_MEMKV = 16 * MiB;
constexpr size_t WS_MKN = 18 * MiB;
constexpr size_t WS_MVT = 19 * MiB;
constexpr size_t WS_WIN = 20 * MiB;
constexpr size_t WS_WKV = 42 * MiB;
constexpr size_t WS_WBR = 46 * MiB;
constexpr size_t WS_WOUT = 52 * MiB;
constexpr size_t WS_ACT = 54 * MiB;
constexpr size_t WS_BIG = WS_ACT;
constexpr size_t WS_HB = WS_BIG + 344 * MiB;
constexpr size_t WS_XB = WS_HB + 64 * MiB;
constexpr size_t WS_VT = WS_XB + 32 * MiB;
constexpr size_t WS_MASK = WS_VT + 32 * MiB;
constexpr size_t WS_RSUM = WS_MASK + 32 * MiB;
constexpr size_t WS_XA = WS_RSUM + 1 * MiB;
constexpr size_t WS_WIN8 = WS_VT + 16 * MiB;
constexpr size_t WS_WBR8 = WS_WIN8 + 11 * MiB;
constexpr size_t WS_HB8 = WS_XA + 32 * MiB;
constexpr size_t WS_END_MIX = WS_HB8 + 32 * MiB;
constexpr size_t WS_WFF = WS_ACT;
constexpr size_t WFF_EXP = 21 * MiB, WFF_DOWN = 14 * MiB;
constexpr size_t WS_H2 = WS_WFF + 168 * MiB;
constexpr size_t WS_HID = WS_H2 + 64 * MiB;
constexpr size_t WS_END_FFN = WS_HID + 238 * MiB;
constexpr size_t WS_NEED = WS_END_MIX > WS_END_FFN ? WS_END_MIX : WS_END_FFN;
static_assert(WS_WFF + 8 * WFF_EXP <= WS_H2 && WS_WFF + 8 * WFF_EXP <= WS_XA, "FFN weights may be converted while XA is live");
static_assert((size_t)SEQ * LDB * 2 <= 344 * MiB && (size_t)MOE_MAXP * 256 * DFF * 2 <= 238 * MiB, "map");
constexpr size_t TAB_TOKE = 0;
constexpr size_t TAB_TOKW = 256 * 1024;
constexpr size_t TAB_CNTB = 512 * 1024;
constexpr size_t TAB_SLOTTOK = 576 * 1024;
constexpr size_t TAB_SLOTW = 896 * 1024;
constexpr size_t TAB_PEXP = 1216 * 1024;
constexpr size_t TAB_NPAN = 1220 * 1024;
static_assert(2 * MOE_MAXP * 256 * 4 <= 320 * 1024, "tab");

constexpr int CW_TMO = 0, CW_CODE = 1, CW_BAR = 4096;

constexpr int RING_BYTES = 155648;
constexpr int LDSCTL_OFF = RING_BYTES, MISC_OFF = LDSCTL_OFF + 2048;
constexpr int LDS_BYTES = 163840;

__device__ __forceinline__ unsigned f2bf(float f) { unsigned u = __builtin_bit_cast(unsigned, f); return (u + 0x7fffu + ((u >> 16) & 1u)) >> 16; }
__device__ __forceinline__ unsigned pk2(float lo, float hi) { return f2bf(lo) | (f2bf(hi) << 16); }
__device__ __forceinline__ float bf2f(unsigned b) { return __builtin_bit_cast(float, b << 16); }
__device__ __forceinline__ float bflo(unsigned w) { return __builtin_bit_cast(float, w << 16); }
__device__ __forceinline__ float bfhi(unsigned w) { return __builtin_bit_cast(float, w & 0xffff0000u); }
__device__ __forceinline__ unsigned cvt_pk_bf16(float lo, float hi) { unsigned r; asm volatile("v_cvt_pk_bf16_f32 %0, %1, %2" : "=v"(r) : "v"(lo), "v"(hi)); return r; }
__device__ __forceinline__ float shfl_xor_l(float v, int o, int lane) { return __builtin_bit_cast(float, __builtin_amdgcn_ds_bpermute((lane ^ o) << 2, __builtin_bit_cast(int, v))); }
__device__ __forceinline__ float wave_sum(float v, int lane) {
#pragma unroll
    for (int o = 1; o < 64; o <<= 1) v += shfl_xor_l(v, o, lane);
    return v;
}
__device__ __forceinline__ float wave_max(float v, int lane) {
#pragma unroll
    for (int o = 1; o < 64; o <<= 1) v = fmaxf(v, shfl_xor_l(v, o, lane));
    return v;
}
__device__ __forceinline__ float fast_exp2(float x) { return __builtin_amdgcn_exp2f(x); }
typedef float f32x2_t __attribute__((ext_vector_type(2)));
__device__ __forceinline__ void unpk4_fp8(unsigned w, float (&o)[4]) { const f32x2_t lo = __builtin_amdgcn_cvt_pk_f32_fp8((int)w, false), hi = __builtin_amdgcn_cvt_pk_f32_fp8((int)w, true); o[0] = lo.x; o[1] = lo.y; o[2] = hi.x; o[3] = hi.y; }
__device__ __forceinline__ unsigned cvt4_fp8(float a, float b, float c, float d) { int w = 0; w = __builtin_amdgcn_cvt_pk_fp8_f32(a, b, w, false); w = __builtin_amdgcn_cvt_pk_fp8_f32(c, d, w, true); return (unsigned)w; }
__device__ __forceinline__ float fast_rcp(float x) { return __builtin_amdgcn_rcpf(x); }
__device__ __forceinline__ float sigmoidf_(float x) { return fast_rcp(1.0f + fast_exp2(-x * LOG2E)); }

namespace pg8 {
#define PG8_LAS __attribute__((address_space(3)))
typedef unsigned short bf16_t;
typedef unsigned u32x4 __attribute__((ext_vector_type(4)));
typedef int v4i_t __attribute__((ext_vector_type(4)));
typedef int v8i_t __attribute__((ext_vector_type(8)));
constexpr int BM = 256, BK = 64, HALF = 128, HTB = HALF * BK * 2, STAGE_BYTES = 8 * HTB, NXCD = 8, WGM = 8;

__host__ __device__ __forceinline__ int lds_byte(int r, int c) { const int st = (r >> 4) * 2 + (c >> 5), rr = r & 15, cc = c & 31, ob = rr * 64 + cc * 2; return st * 1024 + (ob ^ (((ob >> 9) & 1) << 5)); }
__host__ __device__ __forceinline__ void stage_rc(int b, int& R, int& C) { const int st = b / 1024, sb = b % 1024, swz = sb ^ (((sb >> 9) & 1) << 5); R = (st >> 1) * 16 + swz / 64; C = (st & 1) * 32 + (swz % 64) / 2; }
__host__ __device__ __forceinline__ int perm32(int rho) { const int n = rho >> 4, i = rho & 15; return 8 * (i >> 2) + 4 * n + (i & 3); }

struct Unit { int pm, pn; };
struct Gemm { const bf16_t* A; const bf16_t* Bt; int M, N, K, lda, ldb; int kinA = 128, kpairA = 256; };

struct StaticOrder {
    static constexpr bool GATHER = false;
    int nM, nN, nwg, G, c;
    __device__ void init(int M, int N, int G_, int c_) { nM = M / BM; nN = N / BM; nwg = nM * nN; G = G_; c = c_; }
    __device__ bool next(int i, Unit& u) const {
        const long L = (long)i * G + c; if (L >= nwg) return false;
        int wgid = (int)L; { const int q = nwg / NXCD, r = nwg % NXCD, xcd = wgid % NXCD, off = wgid / NXCD; wgid = (xcd < r ? xcd * (q + 1) : r * (q + 1) + (xcd - r) * q) + off; }
        const int nig = WGM * nN, gid = wgid / nig, fm = gid * WGM, gsz = (nM - fm) < WGM ? (nM - fm) : WGM;
        u.pm = fm + ((wgid % nig) % gsz); u.pn = (wgid % nig) / gsz; return true;
    }
    __device__ __forceinline__ const char* a_base(const Gemm& g, const Unit& u) const { return (const char*)(g.A + (size_t)u.pm * BM * g.lda); }
    __device__ __forceinline__ const char* b_base(const Gemm& g, const Unit& u) const { return (const char*)(g.Bt + (size_t)u.pn * BM * g.ldb); }
    __device__ __forceinline__ int a_row(const Unit&, int) const { return 0; }
};
struct TileMapOrder : StaticOrder {
    int split, b0, b1;
    __device__ bool next(int i, Unit& u) const { if (!StaticOrder::next(i, u)) return false; u.pn = u.pn < split ? b0 + u.pn : b1 + (u.pn - split); return true; }
};
struct HeadSliceOrder : StaticOrder {
    __device__ __forceinline__ const char* a_base(const Gemm& g, const Unit& u) const { return (const char*)(g.A + (size_t)u.pm * BM * g.lda + (size_t)u.pn * g.K); }
};
template <bool GATHER_> struct MoeOrder : StaticOrder {
    static constexpr bool GATHER = GATHER_;
    const int* pexp; const int* rowtok; size_t exp_stride;
    __device__ __forceinline__ const char* a_base(const Gemm& g, const Unit& u) const { return GATHER_ ? (const char*)g.A : (const char*)(g.A + (size_t)u.pm * BM * g.lda); }
    __device__ __forceinline__ const char* b_base(const Gemm& g, const Unit& u) const { const int e = __builtin_amdgcn_readfirstlane(pexp[u.pm]); return (const char*)(g.Bt + (size_t)e * exp_stride + (size_t)u.pn * BM * g.ldb); }
    __device__ __forceinline__ int a_row(const Unit& u, int r) const { return rowtok[u.pm * BM + r]; }
};

template <class Epi, class Sched, bool ALIGN_EPI, bool FP8 = false>
__device__ __forceinline__ void gemm_phase(PG8_LAS unsigned char* lds, const Gemm g, const Sched& S, const Epi& E, int wave_id) {
    int lane; asm volatile("v_mbcnt_lo_u32_b32 %0, -1, 0\n\tv_mbcnt_hi_u32_b32 %0, -1, %0" : "=v"(lane));
    const int wid = __builtin_amdgcn_readfirstlane(wave_id), tid = wid * 64 + lane, wr = wid >> 2, wc = wid & 3, fr = lane & 15, fq = lane >> 4;
    const int K = g.K, nt = K / BK;
    unsigned voffA[2][2], voffB[2];
#pragma unroll
    for (int i = 0; i < 2; ++i) { int R, C; stage_rc(tid * 16 + i * 8192, R, C); const int Rb = Epi::P16 ? (64 * (R >> 5) + 16 * ((R & 15) >> 2) + 4 * ((R >> 4) & 1) + (R & 3)) : Epi::PERM ? ((R & ~31) + perm32(R & 31)) : R;
        voffB[i] = (unsigned)(Rb * g.ldb + C) * 2u;
#pragma unroll
        for (int h = 0; h < 2; ++h) voffA[h][i] = (unsigned)(R * g.lda + C) * 2u; }
    const size_t kstep = (size_t)(BK * 2), kinA = (size_t)g.kinA, kpairA = (size_t)g.kpairA;
    const size_t hstepB = (size_t)(Epi::P16 ? 8 : HALF) * g.ldb * 2;
    const size_t hstepA = Sched::GATHER ? (size_t)0 : (size_t)HALF * g.lda * 2;
    const unsigned ldsw = (unsigned)wid * 1024u;
    const int aoff = lds_byte(wr * 64 + fr, fq * 8), boff = lds_byte(wc * 32 + fr, fq * 8);
#define PG8_SA(b, h) (((b) * 2 + (h)) * HTB)
#define PG8_SB(b, h) ((4 + (b) * 2 + (h)) * HTB)
#define PG8_STAGE(bufoff, gbase, voff) do { const char* gb_ = (const char*)(gbase); asm volatile("" : "+s"(gb_));       \
        _Pragma("unroll") for (int _i = 0; _i < 2; ++_i) { unsigned vo_ = (voff)[_i]; asm volatile("" : "+v"(vo_));       \
        __builtin_amdgcn_global_load_lds((const unsigned*)(gb_ + vo_), (PG8_LAS unsigned*)(lds + (bufoff) + ldsw + _i * 8192), 16, 0, 0); } } while (0)
#define PG8_LDA(dst, b, h) do { _Pragma("unroll") for (int m = 0; m < 4; ++m) { const v4i_t x0_ = *(const PG8_LAS v4i_t*)(lds + PG8_SA(b, h) + aoff + m * 2048), x1_ = *(const PG8_LAS v4i_t*)(lds + PG8_SA(b, h) + aoff + m * 2048 + 1024); \
        dst[m] = __builtin_shufflevector(x0_, x1_, 0, 1, 2, 3, 4, 5, 6, 7); } } while (0)
#define PG8_LDB(dst, b, h) do { _Pragma("unroll") for (int n = 0; n < 2; ++n) { const v4i_t x0_ = *(const PG8_LAS v4i_t*)(lds + PG8_SB(b, h) + boff + n * 2048), x1_ = *(const PG8_LAS v4i_t*)(lds + PG8_SB(b, h) + boff + n * 2048 + 1024); \
        dst[n] = __builtin_shufflevector(x0_, x1_, 0, 1, 2, 3, 4, 5, 6, 7); } } while (0)
#define PG8_LO(x_) __builtin_bit_cast(bf16x8, __builtin_shufflevector(x_, x_, 0, 1, 2, 3))
#define PG8_HI(x_) __builtin_bit_cast(bf16x8, __builtin_shufflevector(x_, x_, 4, 5, 6, 7))
#define PG8_MMA(ai, bj, At, Bt) do { __builtin_amdgcn_s_setprio(1); _Pragma("unroll") for (int m = 0; m < 4; ++m) _Pragma("unroll") for (int n = 0; n < 2; ++n) { \
        if constexpr (FP8) acc[ai][bj][m][n] = __builtin_amdgcn_mfma_scale_f32_16x16x128_f8f6f4(Bt[n], At[m], acc[ai][bj][m][n], 0, 0, 0, 0, 0, 0); \
        else { acc[ai][bj][m][n] = __builtin_amdgcn_mfma_f32_16x16x32_bf16(PG8_LO(Bt[n]), PG8_LO(At[m]), acc[ai][bj][m][n], 0, 0, 0); \
               acc[ai][bj][m][n] = __builtin_amdgcn_mfma_f32_16x16x32_bf16(PG8_HI(Bt[n]), PG8_HI(At[m]), acc[ai][bj][m][n], 0, 0, 0); } } \
        __builtin_amdgcn_s_setprio(0); } while (0)
#define PG8_WAIT_V(n) asm volatile("s_waitcnt vmcnt(" #n ")" ::: "memory")
#define PG8_WAIT_L(n) asm volatile("s_waitcnt lgkmcnt(" #n ")" ::: "memory")
#define PG8_BAR __builtin_amdgcn_s_barrier()
#define PG8_SCHED __builtin_amdgcn_sched_barrier(0)
    Unit cur, nxt; int ui = 0;
    if (!S.next(0, cur)) return;
    f32x4 acc[2][2][4][2];
#pragma unroll
    for (int a = 0; a < 2; ++a)
#pragma unroll
        for (int b = 0; b < 2; ++b)
#pragma unroll
            for (int m = 0; m < 4; ++m)
#pragma unroll
                for (int n = 0; n < 2; ++n) acc[a][b][m][n] = (f32x4){0.f, 0.f, 0.f, 0.f};
    v8i_t At[4], B0[2], B1[2];
    const char* cA = S.a_base(g, cur); const char* cB = S.b_base(g, cur);
    if constexpr (Sched::GATHER) {
#pragma unroll
        for (int h = 0; h < 2; ++h)
#pragma unroll
            for (int i = 0; i < 2; ++i) { int R, C; stage_rc(tid * 16 + i * 8192, R, C); voffA[h][i] = (unsigned)(S.a_row(cur, h * HALF + R) * g.lda + C) * 2u; }
    }
    PG8_STAGE(PG8_SB(0, 0), cB, voffB); PG8_STAGE(PG8_SB(0, 1), cB + hstepB, voffB); PG8_STAGE(PG8_SA(0, 0), cA, voffA[0]); PG8_STAGE(PG8_SA(0, 1), cA + hstepA, voffA[1]);
    PG8_STAGE(PG8_SB(1, 0), cB + kstep, voffB); PG8_STAGE(PG8_SA(1, 0), cA + kinA, voffA[0]); PG8_STAGE(PG8_SB(1, 1), cB + hstepB + kstep, voffB);
    if (wr == 1) PG8_BAR;
    PG8_WAIT_V(8); PG8_BAR;
    PG8_WAIT_V(6); PG8_BAR;
    for (;;) {
        const bool has_next = S.next(ui + 1, nxt);
        const char* nA = has_next ? S.a_base(g, nxt) : cA; const char* nB = has_next ? S.b_base(g, nxt) : cB;
#pragma nounroll
        for (int t = 0; t < nt; t += 2) {
            const bool last = (t == nt - 2);
            const char* a1 = cA + (size_t)(t >> 1) * kpairA + kinA;
            const char* a2 = last ? nA : cA + (size_t)((t >> 1) + 1) * kpairA; const char* b2 = last ? nB : cB + (size_t)(t + 2) * kstep;
            const char* a3 = a2 + kinA; const char* b3 = b2 + kstep;
            PG8_LDB(B0, 0, 0); PG8_LDB(B1, 0, 1); PG8_SCHED; PG8_LDA(At, 0, 0); PG8_STAGE(PG8_SA(1, 1), a1 + hstepA, voffA[1]);
            if constexpr (Sched::GATHER) {
                if (last && has_next) {
#pragma unroll
                    for (int h = 0; h < 2; ++h)
#pragma unroll
                        for (int i = 0; i < 2; ++i) { int R, C; stage_rc(tid * 16 + i * 8192, R, C); voffA[h][i] = (unsigned)(S.a_row(nxt, h * HALF + R) * g.lda + C) * 2u; }
                }
            }
            PG8_WAIT_V(8); PG8_WAIT_L(0); PG8_BAR; PG8_MMA(0, 0, At, B0); PG8_MMA(0, 1, At, B1); PG8_BAR; PG8_SCHED;
            PG8_LDA(At, 0, 1); PG8_STAGE(PG8_SB(0, 0), b2, voffB); PG8_STAGE(PG8_SB(0, 1), b2 + hstepB, voffB); PG8_STAGE(PG8_SA(0, 0), a2, voffA[0]);
            PG8_WAIT_V(8); PG8_WAIT_L(0); PG8_BAR; PG8_MMA(1, 0, At, B0); PG8_MMA(1, 1, At, B1); PG8_BAR; PG8_SCHED;
            PG8_LDB(B0, 1, 0); PG8_LDB(B1, 1, 1); PG8_SCHED; PG8_LDA(At, 1, 0); PG8_STAGE(PG8_SA(0, 1), a2 + hstepA, voffA[1]);
            PG8_WAIT_V(8); PG8_WAIT_L(0); PG8_BAR; PG8_MMA(0, 0, At, B0); PG8_MMA(0, 1, At, B1); PG8_BAR; PG8_SCHED;
            PG8_LDA(At, 1, 1); PG8_STAGE(PG8_SB(1, 0), b3, voffB); PG8_STAGE(PG8_SB(1, 1), b3 + hstepB, voffB); PG8_STAGE(PG8_SA(1, 0), a3, voffA[0]);
            PG8_WAIT_V(8); PG8_WAIT_L(0); PG8_BAR; PG8_MMA(1, 0, At, B0); PG8_MMA(1, 1, At, B1); PG8_BAR; PG8_SCHED;
        }
        if constexpr (ALIGN_EPI) { if (wr == 0) PG8_BAR; }
        { int l2_; asm volatile("v_mbcnt_lo_u32_b32 %0, -1, 0\n\tv_mbcnt_hi_u32_b32 %0, -1, %0" : "=v"(l2_));
          E(acc, cur, wr, wc, l2_ & 15, l2_ >> 4); }
        if (!has_next) break;
#pragma unroll
        for (int a = 0; a < 2; ++a)
#pragma unroll
            for (int b = 0; b < 2; ++b)
#pragma unroll
                for (int m = 0; m < 4; ++m)
#pragma unroll
                    for (int n = 0; n < 2; ++n) acc[a][b][m][n] = (f32x4){0.f, 0.f, 0.f, 0.f};
        cur = nxt; cA = nA; cB = nB; ++ui;
        if constexpr (ALIGN_EPI) { if (wr == 1) PG8_BAR; }
    }
    PG8_WAIT_V(0);
    if constexpr (!ALIGN_EPI) { if (wr == 0) PG8_BAR; }
    PG8_BAR;
#undef PG8_SA
#undef PG8_SB
#undef PG8_STAGE
#undef PG8_LDA
#undef PG8_LDB
#undef PG8_MMA
#undef PG8_LO
#undef PG8_HI
#undef PG8_WAIT_V
#undef PG8_WAIT_L
#undef PG8_BAR
#undef PG8_SCHED
}

typedef const f32x4 (&AccRef)[2][2][4][2];
struct EpiF8S {
    static constexpr bool PERM = true;
    static constexpr bool P16 = true;
    unsigned char* O; int ldcb; float osc;
    __device__ __forceinline__ void operator()(AccRef acc, const Unit& u, int wr, int wc, int fr, int fq) const {
        const int row0 = u.pm * BM + wr * 64 + fr, colb = u.pn * 512 + wc * 64 + 16 * fq;
#pragma unroll
        for (int ai = 0; ai < 2; ++ai)
#pragma unroll
            for (int m = 0; m < 4; ++m) { u32x4 w; f32x4 v;
                v = acc[ai][0][m][0] * osc; w.x = cvt4_fp8(v[0], v[1], v[2], v[3]); v = acc[ai][0][m][1] * osc; w.y = cvt4_fp8(v[0], v[1], v[2], v[3]);
                v = acc[ai][1][m][0] * osc; w.z = cvt4_fp8(v[0], v[1], v[2], v[3]); v = acc[ai][1][m][1] * osc; w.w = cvt4_fp8(v[0], v[1], v[2], v[3]);
                *(u32x4*)(O + (size_t)(row0 + ai * HALF + m * 16) * ldcb + colb) = w; }
    }
};
struct EpiBf16P {
    static constexpr bool PERM = true;
    static constexpr bool P16 = false;
    bf16_t* O; int ldc;
    __device__ __forceinline__ void operator()(AccRef acc, const Unit& u, int wr, int wc, int fr, int fq) const {
        const int row0 = u.pm * BM + wr * 64 + fr, col0 = u.pn * BM + wc * 32 + 8 * fq;
        if (u.pn >= 4 && u.pn < 12) {
#pragma unroll
            for (int ai = 0; ai < 2; ++ai)
#pragma unroll
                for (int m = 0; m < 4; ++m) { const f32x4 v0 = acc[ai][0][m][0] * acc[ai][1][m][0], v1 = acc[ai][0][m][1] * acc[ai][1][m][1];
                    u32x4 w; w.x = cvt_pk_bf16(v0[0], v0[1]); w.y = cvt_pk_bf16(v0[2], v0[3]); w.z = cvt_pk_bf16(v1[0], v1[1]); w.w = cvt_pk_bf16(v1[2], v1[3]);
                    *(u32x4*)(O + (size_t)(row0 + ai * HALF + m * 16) * ldc + col0) = w; }
        } else {
#pragma unroll
            for (int ai = 0; ai < 2; ++ai)
#pragma unroll
                for (int m = 0; m < 4; ++m) { bf16_t* rowp = O + (size_t)(row0 + ai * HALF + m * 16) * ldc + col0;
#pragma unroll
                    for (int bj = 0; bj < 2; ++bj) { const f32x4 v0 = acc[ai][bj][m][0], v1 = acc[ai][bj][m][1];
                        u32x4 w; w.x = cvt_pk_bf16(v0[0], v0[1]); w.y = cvt_pk_bf16(v0[2], v0[3]); w.z = cvt_pk_bf16(v1[0], v1[1]); w.w = cvt_pk_bf16(v1[2], v1[3]);
                        *(u32x4*)(rowp + bj * HALF) = w; } }
        }
    }
};
struct EpiBf16 {
    static constexpr bool PERM = true;
    static constexpr bool P16 = false;
    bf16_t* O; int ldc;
    __device__ __forceinline__ void operator()(AccRef acc, const Unit& u, int wr, int wc, int fr, int fq) const {
        const int row0 = u.pm * BM + wr * 64 + fr, col0 = u.pn * BM + wc * 32 + 8 * fq;
#pragma unroll
        for (int ai = 0; ai < 2; ++ai)
#pragma unroll
            for (int m = 0; m < 4; ++m) { bf16_t* rowp = O + (size_t)(row0 + ai * HALF + m * 16) * ldc + col0;
#pragma unroll
                for (int bj = 0; bj < 2; ++bj) { const f32x4 v0 = acc[ai][bj][m][0], v1 = acc[ai][bj][m][1];
                    u32x4 w; w.x = cvt_pk_bf16(v0[0], v0[1]); w.y = cvt_pk_bf16(v0[2], v0[3]); w.z = cvt_pk_bf16(v1[0], v1[1]); w.w = cvt_pk_bf16(v1[2], v1[3]);
                    *(u32x4*)(rowp + bj * HALF) = w; } }
    }
};
struct EpiMemP {
    static constexpr bool PERM = true;
    static constexpr bool P16 = false;
    bf16_t* O; int ldc; float* rowsum; float shift;
    __device__ __forceinline__ void operator()(AccRef acc, const Unit& u, int wr, int wc, int fr, int fq) const {
        const int row0 = u.pm * BM + wr * 64 + fr, col0 = u.pn * BM + wc * 32 + 8 * fq;
#pragma unroll
        for (int ai = 0; ai < 2; ++ai)
#pragma unroll
            for (int m = 0; m < 4; ++m) { const int row = row0 + ai * HALF + m * 16; bf16_t* rowp = O + (size_t)row * ldc + col0; float s = 0.f;
#pragma unroll
                for (int bj = 0; bj < 2; ++bj) { f32x4 v0 = acc[ai][bj][m][0], v1 = acc[ai][bj][m][1];
#pragma unroll
                    for (int j = 0; j < 4; ++j) { v0[j] = fast_exp2(v0[j] - shift); v1[j] = fast_exp2(v1[j] - shift); }
                    u32x4 w; w.x = cvt_pk_bf16(v0[0], v0[1]); w.y = cvt_pk_bf16(v0[2], v0[3]); w.z = cvt_pk_bf16(v1[0], v1[1]); w.w = cvt_pk_bf16(v1[2], v1[3]);
                    s += (bflo(w.x) + bfhi(w.x)) + (bflo(w.y) + bfhi(w.y)) + (bflo(w.z) + bfhi(w.z)) + (bflo(w.w) + bfhi(w.w));
                    *(u32x4*)(rowp + bj * HALF) = w; asm volatile("" ::: "memory"); }
                s += shfl_xor_l(s, 16, fr + 16 * fq); s += shfl_xor_l(s, 32, fr + 16 * fq);
                if (fq == 0) atomicAdd(rowsum + (size_t)row * 4 + u.pn, s);
                asm volatile("" ::: "memory"); }
    }
};
struct EpiMemO {
    static constexpr bool PERM = true;
    static constexpr bool P16 = false;
    unsigned char* O; int ldcb; const float* rowsum; float osc;
    __device__ __forceinline__ void operator()(AccRef acc, const Unit& u, int wr, int wc, int fr, int fq) const {
        const int row0 = u.pm * BM + wr * 64 + fr, colb = u.pn * 512 + wc * 32 + 8 * fq;
        float rs8[2][4];
#pragma unroll
        for (int ai = 0; ai < 2; ++ai)
#pragma unroll
            for (int m = 0; m < 4; ++m) rs8[ai][m] = __hip_atomic_load(rowsum + (size_t)(row0 + ai * HALF + m * 16) * 4 + u.pn, __ATOMIC_RELAXED, __HIP_MEMORY_SCOPE_AGENT);
#pragma unroll
        for (int ai = 0; ai < 2; ++ai)
#pragma unroll
            for (int m = 0; m < 4; ++m) { const int row = row0 + ai * HALF + m * 16; unsigned char* rowp = O + (size_t)row * ldcb + colb;
                const float inv = osc / rs8[ai][m];
#pragma unroll
                for (int bj = 0; bj < 2; ++bj) { const f32x4 v0 = acc[ai][bj][m][0] * inv, v1 = acc[ai][bj][m][1] * inv;
                    v2u w; w.x = cvt4_fp8(v0[0], v0[1], v0[2], v0[3]); w.y = cvt4_fp8(v1[0], v1[1], v1[2], v1[3]);
                    *(v2u*)(rowp + bj * HALF) = w; }
                asm volatile("" ::: "memory"); }
    }
};
struct EpiGate {
    static constexpr bool PERM = true;
    static constexpr bool P16 = false;
    const unsigned char* gate; int ldgb; const bf16_t* prev; bf16_t* O; int ldc; float osc;
    __device__ __forceinline__ void operator()(AccRef acc, const Unit& u, int wr, int wc, int fr, int fq) const {
        const int row0 = u.pm * BM + wr * 64 + fr, col0 = u.pn * BM + wc * 32 + 8 * fq;
#pragma unroll
        for (int ai = 0; ai < 2; ++ai) {
            v2u gw[4][2]; u32x4 pw[4][2];
#pragma unroll
            for (int m = 0; m < 4; ++m)
#pragma unroll
                for (int bj = 0; bj < 2; ++bj) { const size_t row = (size_t)(row0 + ai * HALF + m * 16); const int col = col0 + bj * HALF;
                    gw[m][bj] = *(const v2u*)(gate + row * ldgb + u.pn * 512 + wc * 32 + 8 * fq + bj * HALF);
                    pw[m][bj] = prev ? *(const u32x4*)(prev + row * ldc + col) : (u32x4){0u, 0u, 0u, 0u}; }
#pragma unroll
            for (int m = 0; m < 4; ++m)
#pragma unroll
                for (int bj = 0; bj < 2; ++bj) { const size_t row = (size_t)(row0 + ai * HALF + m * 16); const int col = col0 + bj * HALF;
                    const u32x4 p4 = pw[m][bj]; float ga[4], gb[4]; unpk4_fp8(gw[m][bj].x, ga); unpk4_fp8(gw[m][bj].y, gb);
                    f32x4 v0 = acc[ai][bj][m][0] * osc, v1 = acc[ai][bj][m][1] * osc;
                    v0[0] = v0[0] * sigmoidf_(ga[0]) + bflo(p4.x); v0[1] = v0[1] * sigmoidf_(ga[1]) + bfhi(p4.x); v0[2] = v0[2] * sigmoidf_(ga[2]) + bflo(p4.y); v0[3] = v0[3] * sigmoidf_(ga[3]) + bfhi(p4.y);
                    v1[0] = v1[0] * sigmoidf_(gb[0]) + bflo(p4.z); v1[1] = v1[1] * sigmoidf_(gb[1]) + bfhi(p4.z); v1[2] = v1[2] * sigmoidf_(gb[2]) + bflo(p4.w); v1[3] = v1[3] * sigmoidf_(gb[3]) + bfhi(p4.w);
                    u32x4 w; w.x = cvt_pk_bf16(v0[0], v0[1]); w.y = cvt_pk_bf16(v0[2], v0[3]); w.z = cvt_pk_bf16(v1[0], v1[1]); w.w = cvt_pk_bf16(v1[2], v1[3]);
                    *(u32x4*)(O + row * ldc + col) = w; }
            asm volatile("" ::: "memory"); }
    }
};
struct EpiResid {
    static constexpr bool PERM = false;
    static constexpr bool P16 = false;
    const float* res; float* out; int ldc; float osc;
    __device__ __forceinline__ void operator()(AccRef acc, const Unit& u, int wr, int wc, int fr, int fq) const {
        const int row0 = u.pm * BM + wr * 64 + fr, col0 = u.pn * BM + wc * 32 + 4 * fq;
#pragma unroll
        for (int ai = 0; ai < 2; ++ai)
#pragma unroll
            for (int mh = 0; mh < 1; ++mh) {
                f32x4 r[4][2][2];
#pragma unroll
                for (int mm = 0; mm < 4; ++mm) { const size_t off = (size_t)(row0 + ai * HALF + (4 * mh + mm) * 16) * ldc + col0;
#pragma unroll
                    for (int bj = 0; bj < 2; ++bj)
#pragma unroll
                        for (int n = 0; n < 2; ++n) r[mm][bj][n] = *(const f32x4*)(res + off + bj * HALF + n * 16); }
#pragma unroll
                for (int mm = 0; mm < 4; ++mm) { const int m = 4 * mh + mm; const size_t off = (size_t)(row0 + ai * HALF + m * 16) * ldc + col0;
#pragma unroll
                    for (int bj = 0; bj < 2; ++bj)
#pragma unroll
                        for (int n = 0; n < 2; ++n) *(f32x4*)(out + off + bj * HALF + n * 16) = r[mm][bj][n] + acc[ai][bj][m][n] * osc; }
                asm volatile("" ::: "memory"); }
    }
};
struct EpiSwiGLU {
    static constexpr bool PERM = true;
    static constexpr bool P16 = false;
    bf16_t* O; int ldc;
    __device__ __forceinline__ void operator()(AccRef acc, const Unit& u, int wr, int wc, int fr, int fq) const {
        const int row0 = u.pm * BM + wr * 64 + fr, col0 = u.pn * HALF + wc * 32 + 8 * fq;
#pragma unroll
        for (int ai = 0; ai < 2; ++ai)
#pragma unroll
            for (int m = 0; m < 4; ++m) { bf16_t* rowp = O + (size_t)(row0 + ai * HALF + m * 16) * ldc + col0;
                f32x4 h0, h1;
#pragma unroll
                for (int j = 0; j < 4; ++j) { const float g0 = acc[ai][0][m][0][j], g1 = acc[ai][0][m][1][j];
                    h0[j] = g0 * sigmoidf_(g0) * acc[ai][1][m][0][j]; h1[j] = g1 * sigmoidf_(g1) * acc[ai][1][m][1][j]; }
                u32x4 w; w.x = cvt_pk_bf16(h0[0], h0[1]); w.y = cvt_pk_bf16(h0[2], h0[3]); w.z = cvt_pk_bf16(h1[0], h1[1]); w.w = cvt_pk_bf16(h1[2], h1[3]);
                *(u32x4*)rowp = w; }
    }
};
struct EpiSwiGLU8 {
    static constexpr bool PERM = true;
    static constexpr bool P16 = false;
    unsigned char* O; int ldc; float isc, osc;
    __device__ __forceinline__ void operator()(AccRef acc, const Unit& u, int wr, int wc, int fr, int fq) const {
        const int row0 = u.pm * BM + wr * 64 + fr, col0 = u.pn * HALF + wc * 32 + 8 * fq; const float so = isc * osc;
#pragma unroll
        for (int ai = 0; ai < 2; ++ai)
#pragma unroll
            for (int m = 0; m < 4; ++m) { unsigned char* rowp = O + (size_t)(row0 + ai * HALF + m * 16) * ldc + col0;
                f32x4 h0, h1;
#pragma unroll
                for (int j = 0; j < 4; ++j) { const float g0 = acc[ai][0][m][0][j] * isc, g1 = acc[ai][0][m][1][j] * isc;
                    h0[j] = __builtin_amdgcn_fmed3f(g0 * sigmoidf_(g0) * (acc[ai][1][m][0][j] * so), -448.0f, 448.0f); h1[j] = __builtin_amdgcn_fmed3f(g1 * sigmoidf_(g1) * (acc[ai][1][m][1][j] * so), -448.0f, 448.0f); }
                v2u w; w.x = cvt4_fp8(h0[0], h0[1], h0[2], h0[3]); w.y = cvt4_fp8(h1[0], h1[1], h1[2], h1[3]);
                *(v2u*)rowp = w; }
    }
};
struct EpiMoeDown {
    static constexpr bool PERM = false;
    static constexpr bool P16 = false;
    const int* rowtok; const float* roww; float* out; int ldc; float wsc;
    __device__ __forceinline__ void operator()(AccRef acc, const Unit& u, int wr, int wc, int fr, int fq) const {
        const int row0 = u.pm * BM + wr * 64 + fr, col0 = u.pn * BM + wc * 32 + 4 * fq;
        float w8[2][4]; int t8[2][4];
#pragma unroll
        for (int ai = 0; ai < 2; ++ai)
#pragma unroll
            for (int m = 0; m < 4; ++m) { const int row = row0 + ai * HALF + m * 16; w8[ai][m] = roww[row] * wsc; t8[ai][m] = rowtok[row]; }
#pragma unroll
        for (int ai = 0; ai < 2; ++ai) {
            f32x4 r[4][2][2];
#pragma unroll
            for (int m = 0; m < 4; ++m) { const size_t off = (size_t)t8[ai][m] * ldc + col0;
#pragma unroll
                for (int bj = 0; bj < 2; ++bj)
#pragma unroll
                    for (int n = 0; n < 2; ++n) r[m][bj][n] = *(const f32x4*)(out + off + bj * HALF + n * 16); }
#pragma unroll
            for (int m = 0; m < 4; ++m) { const float w = w8[ai][m]; const size_t off = (size_t)t8[ai][m] * ldc + col0;
                if (w != 0.f) {
#pragma unroll
                    for (int bj = 0; bj < 2; ++bj)
#pragma unroll
                        for (int n = 0; n < 2; ++n) *(f32x4*)(out + off + bj * HALF + n * 16) = r[m][bj][n] + acc[ai][bj][m][n] * w; } }
            asm volatile("" ::: "memory"); }
    }
};
struct TailOrder {
    static constexpr bool GATHER = false;
    int nsub, c, nsplit, kpart; const int* pexp; size_t exp_stride;
    __device__ bool next(int i, Unit& u) const { if (i != 0 || c >= nsub) return false; const int tu = c / nsplit; u.pm = 128 + (tu >> 2); u.pn = tu & 3; return true; }
    __device__ __forceinline__ const char* a_base(const Gemm& g, const Unit& u) const { return (const char*)(g.A + (size_t)u.pm * BM * g.lda + (size_t)(c % nsplit) * kpart); }
    __device__ __forceinline__ const char* b_base(const Gemm& g, const Unit& u) const { const int e = __builtin_amdgcn_readfirstlane(pexp[u.pm]); return (const char*)(g.Bt + (size_t)e * exp_stride + (size_t)u.pn * BM * g.ldb + (size_t)(c % nsplit) * kpart); }
    __device__ __forceinline__ int a_row(const Unit&, int) const { return 0; }
};
struct EpiPartF32 {
    static constexpr bool PERM = false;
    static constexpr bool P16 = false;
    float* tile;
    __device__ __forceinline__ void operator()(AccRef acc, const Unit&, int wr, int wc, int fr, int fq) const {
        const int row0 = wr * 64 + fr, col0 = wc * 32 + 4 * fq;
#pragma unroll
        for (int ai = 0; ai < 2; ++ai)
#pragma unroll
            for (int m = 0; m < 4; ++m) { float* rp = tile + (size_t)(row0 + ai * HALF + m * 16) * BM + col0;
#pragma unroll
                for (int bj = 0; bj < 2; ++bj)
#pragma unroll
                    for (int n = 0; n < 2; ++n) *(f32x4*)(rp + bj * HALF + n * 16) = acc[ai][bj][m][n]; }
    }
};
}

#define XB_TMO      128
#define XB_XCNT(j)  (256  + 64 * (j))
#define XB_XSUB(j)  (1280 + 64 * (j))
#define XB_XGEN(j)  (2304 + 64 * (j))
#define XB_TOP      3328
#define XB_TOPGEN   3392
#define XCD_BAR_WORDS 3456
#define XB_SPIN_CAP (1u << 22)

__device__ __forceinline__ unsigned xb_ld(unsigned* p)              { return __hip_atomic_load(p, __ATOMIC_RELAXED, __HIP_MEMORY_SCOPE_AGENT); }
__device__ __forceinline__ unsigned xb_add(unsigned* p, unsigned v) { return __hip_atomic_fetch_add(p, v, __ATOMIC_RELAXED, __HIP_MEMORY_SCOPE_AGENT); }
__device__ __forceinline__ unsigned xb_xcc_id() { return (unsigned)__builtin_amdgcn_s_getreg((3 << 11) | 20) & 0xFu; }
#define XB_SPIN(cond, bar) do { unsigned _sp = 0; while (cond) { __builtin_amdgcn_s_sleep(1); \
    if ((++_sp & 255u) == 0u) { if (xb_ld(&(bar)[XB_TMO])) break; if (_sp > XB_SPIN_CAP) { atomicAdd(&(bar)[XB_TMO], 1u); break; } } } } while (0)

struct XcdBarrier { unsigned* bar; unsigned x; volatile LAS unsigned* st; };

__device__ __forceinline__ XcdBarrier xcd_barrier_post(unsigned* bar, volatile LAS unsigned* st) {
    XcdBarrier b; b.bar = bar; b.x = xb_xcc_id(); b.st = st;
    if (threadIdx.x == 0) (void)xb_add(&bar[XB_XCNT(b.x)], 1u);
    return b;
}
__device__ __forceinline__ void xcd_barrier_complete(unsigned* bar, unsigned x, unsigned& nloc, unsigned& nx) {
    const unsigned G = gridDim.x * gridDim.y * gridDim.z;
    unsigned sum, cnt, mine, sp = 0u;
    for (;;) {
        sum = 0u; cnt = 0u; mine = 0u;
#pragma unroll
        for (unsigned j = 0; j < 16; ++j) { const unsigned c = xb_ld(&bar[XB_XCNT(j)]); sum += c; cnt += (c > 0u) ? 1u : 0u; mine = (j == x) ? c : mine; }
        if (sum == G) break;
        __builtin_amdgcn_s_sleep(1);
        if ((++sp & 255u) == 0u) { if (xb_ld(&bar[XB_TMO])) break; if (sp > XB_SPIN_CAP) { atomicAdd(&bar[XB_TMO], 1u); break; } }
    }
    nloc = mine > 0u ? mine : 1u; nx = cnt > 0u ? cnt : 1u;
}
__device__ __forceinline__ void xcd_barrier(const XcdBarrier& b, int tid) {
    asm volatile("s_waitcnt vmcnt(0)" ::: "memory");
    __syncthreads();
    if (tid == 0) {
        unsigned* bar = b.bar;
        __builtin_amdgcn_s_waitcnt(0);
        unsigned nloc = b.st[0], nx = b.st[1];
        if (nloc == 0u) { xcd_barrier_complete(bar, b.x, nloc, nx); b.st[0] = nloc; b.st[1] = nx; }
        const unsigned old = xb_add(&bar[XB_XSUB(b.x)], 1u);
        const unsigned gen = old / nloc;
        if (old + 1u == (gen + 1u) * nloc) {
            __builtin_amdgcn_fence(__ATOMIC_RELEASE, "agent");
            asm volatile("s_waitcnt vmcnt(0)" ::: "memory");
            const unsigned og = xb_add(&bar[XB_TOP], 1u);
            const unsigned tg = og / nx;
            if (og + 1u == (tg + 1u) * nx) xb_add(&bar[XB_TOPGEN], 1u);
            else XB_SPIN(xb_ld(&bar[XB_TOPGEN]) == tg, bar);
            __builtin_amdgcn_fence(__ATOMIC_ACQUIRE, "agent");
            xb_add(&bar[XB_XGEN(b.x)], 1u);
            asm volatile("s_waitcnt vmcnt(0)" ::: "memory");
        } else {
            XB_SPIN(xb_ld(&bar[XB_XGEN(b.x)]) == gen, bar);
            __builtin_amdgcn_fence(__ATOMIC_ACQUIRE, "agent");
            asm volatile("s_waitcnt vmcnt(0)" ::: "memory");
        }
    }
    __syncthreads();
}

typedef const float* const __attribute__((address_space(4)))* InPtrs;
struct Frame {
    LAS unsigned char* lds;
    int tid, lane, wave, bid, gw;
    unsigned char* ws;
};
constexpr int NGW = GRID * NWAVES;

__device__ __forceinline__ void glds16(const void* gsrc, unsigned lds_dst) { unsigned keep;
    asm volatile("s_mov_b32 %0, m0\n\ts_mov_b32 m0, %2\n\ts_nop 0\n\tglobal_load_lds_dwordx4 %1, off\n\ts_mov_b32 m0, %0" : "=&s"(keep) : "v"(gsrc), "s"(lds_dst) : "memory"); }
__device__ __forceinline__ void glds4(const void* gsrc, unsigned lds_dst) { unsigned keep;
    asm volatile("s_mov_b32 %0, m0\n\ts_mov_b32 m0, %2\n\ts_nop 0\n\tglobal_load_lds_dword %1, off\n\ts_mov_b32 m0, %0" : "=&s"(keep) : "v"(gsrc), "s"(lds_dst) : "memory"); }

__device__ __forceinline__ void glds16s(unsigned voff, const void* sbase, unsigned lds_dst) { unsigned keep;
    asm volatile("s_mov_b32 %0, m0\n\ts_mov_b32 m0, %3\n\ts_nop 0\n\tglobal_load_lds_dwordx4 %1, %2\n\ts_mov_b32 m0, %0" : "=&s"(keep) : "v"(voff), "s"(sbase), "s"(lds_dst) : "memory"); }
__device__ __forceinline__ void glds4s(unsigned voff, const void* sbase, unsigned lds_dst) { unsigned keep;
    asm volatile("s_mov_b32 %0, m0\n\ts_mov_b32 m0, %3\n\ts_nop 0\n\tglobal_load_lds_dword %1, %2\n\ts_mov_b32 m0, %0" : "=&s"(keep) : "v"(voff), "s"(sbase), "s"(lds_dst) : "memory"); }

struct MapOff { int off; __device__ __forceinline__ int operator()(int n) const { return off + n; } };
struct MapWin { __device__ __forceinline__ int operator()(int n) const { return n < 6728 ? n : n + 184; } };
struct MapWinP { __device__ __forceinline__ int operator()(int n) const { return n < 1024 ? n : n < 2048 ? 1024 + ((n - 1024) >> 7) * 256 + ((n - 1024) & 127) : n < 3072 ? 1024 + ((n - 2048) >> 7) * 256 + 128 + ((n - 2048) & 127) : n < 6728 ? n : n + 184; } };
struct MapGU  { int up; __device__ __forceinline__ int operator()(int n) const { return (n >> 7) * 256 + up * 128 + (n & 127); } };
template <class Map> __device__ __forceinline__ void transpose_item(const float* W, int K, int N, bf16* WT, const Map map, LAS unsigned* scr, int item, int lane) {
    const int nblk = (N + 63) / 64, kb = item / nblk, nb = item % nblk, k0 = 64 * kb, n0 = 64 * nb;
    const int c4 = lane & 15, kr = lane >> 4, ncol = n0 + 4 * c4;
    const bool colok = ncol < N;
    const float* src = W + (size_t)(k0 + 2 * kr) * N + ncol;
    f32x4 v0[8], v1[8];
#pragma unroll
    for (int i = 0; i < 8; ++i) { if (colok) { v0[i] = *(const GAS f32x4*)(src + (size_t)(8 * i) * N); v1[i] = *(const GAS f32x4*)(src + (size_t)(8 * i + 1) * N); } else { v0[i] = (f32x4){0.f, 0.f, 0.f, 0.f}; v1[i] = v0[i]; } }
#pragma unroll
    for (int i = 0; i < 8; ++i) { const int pw = 4 * i + kr;
#pragma unroll
        for (int j = 0; j < 4; ++j) { const int n = 4 * c4 + j; scr[n * 32 + (pw ^ ((c4 & 7) << 2))] = cvt_pk_bf16(v0[i][j], v1[i][j]); } }
    LDS_WAIT(); asm volatile("" ::: "memory");
    const int q = lane & 7;
#pragma unroll
    for (int it = 0; it < 8; ++it) { const int n = (lane >> 3) + 8 * it;
        const v4u o = *(const LAS v4u*)(scr + n * 32 + ((q ^ ((n >> 2) & 7)) << 2));
        if (n0 + n < N) *(GAS v4u*)(WT + (size_t)map(n0 + n) * K + k0 + 8 * q) = o; }
    LDS_WAIT(); asm volatile("" ::: "memory");
}
template <class Map> __device__ __forceinline__ void transpose_item8(const float* W, int K, int N, unsigned char* WT8, const Map map, float sc, int item, int lane) {
    const int nblk = (N + 63) / 64, kb = item / nblk, nb = item % nblk, k0 = 64 * kb, n0 = 64 * nb;
    const int c4 = lane & 15, kr = lane >> 4;
    if (n0 + 4 * c4 >= N) return;
    const float* src = W + (size_t)(k0 + 16 * kr) * N + n0 + 4 * c4;
    f32x4 v[16];
#pragma unroll
    for (int i = 0; i < 16; ++i) v[i] = *(const GAS f32x4*)(src + (size_t)i * N) * sc;
#pragma unroll
    for (int j = 0; j < 4; ++j) { v4u o;
        o.x = cvt4_fp8(v[0][j], v[1][j], v[2][j], v[3][j]); o.y = cvt4_fp8(v[4][j], v[5][j], v[6][j], v[7][j]); o.z = cvt4_fp8(v[8][j], v[9][j], v[10][j], v[11][j]); o.w = cvt4_fp8(v[12][j], v[13][j], v[14][j], v[15][j]);
        *(GAS v4u*)(WT8 + (size_t)map(n0 + 4 * c4 + j) * K + k0 + 16 * kr) = o; }
}
template <class Map> __device__ __forceinline__ void transpose_matrix8(const Frame& F, const float* W, int K, int N, unsigned char* WT8, const Map map, float sc, int& rot) {
    const int nitems = (K / 64) * ((N + 63) / 64);
    for (int it = (F.gw + NGW - rot) % NGW; it < nitems; it += NGW) transpose_item8(W, K, N, WT8, map, sc, it, F.lane);
    rot = (rot + nitems) % NGW;
}
template <class Map> __device__ __forceinline__ void transpose_matrix(const Frame& F, const float* W, int K, int N, bf16* WT, const Map map, int& rot) {
    LAS unsigned* scr = (LAS unsigned*)(F.lds + F.wave * 16384);
    const int nitems = (K / 64) * ((N + 63) / 64);
    for (int it = (F.gw + NGW - rot) % NGW; it < nitems; it += NGW) transpose_item(W, K, N, WT, map, scr, it, F.lane);
    rot = (rot + nitems) % NGW;
}

__device__ __forceinline__ void rms_load(const float* xrow, int lane, f32x4 (&y)[4]) {
    const GAS f32x4* xr = (const GAS f32x4*)xrow + lane;
#pragma unroll
    for (int j = 0; j < 4; ++j) y[j] = xr[64 * j];
}
__device__ __forceinline__ void rms_norm(const f32x4 (&g4)[4], int lane, f32x4 (&y)[4]) {
    float ss = 0.f;
#pragma unroll
    for (int j = 0; j < 4; ++j) ss += (y[j].x * y[j].x + y[j].y * y[j].y) + (y[j].z * y[j].z + y[j].w * y[j].w);
    const float r = 1.0f / sqrtf(wave_sum(ss, lane) * (1.0f / 1024.0f) + EPS);
#pragma unroll
    for (int j = 0; j < 4; ++j) y[j] = y[j] * r * g4[j];
}
__device__ __forceinline__ void gain_load(const float* g, int lane, f32x4 (&g4)[4]) {
    const GAS f32x4* gr = (const GAS f32x4*)g + lane;
#pragma unroll
    for (int j = 0; j < 4; ++j) g4[j] = gr[64 * j];
}
__device__ __forceinline__ void row_store_bf16(bf16* orow, int lane, const f32x4 (&y)[4]) {
    GAS v2u* o8 = (GAS v2u*)orow + lane;
#pragma unroll
    for (int j = 0; j < 4; ++j) { v2u w; w.x = pk2(y[j].x, y[j].y); w.y = pk2(y[j].z, y[j].w); o8[64 * j] = w; }
}
__device__ __forceinline__ void row_store_fp8(unsigned char* orow, int lane, const f32x4 (&y)[4]) {
    GAS unsigned* o4 = (GAS unsigned*)orow + lane;
#pragma unroll
    for (int j = 0; j < 4; ++j) o4[64 * j] = cvt4_fp8(y[j].x, y[j].y, y[j].z, y[j].w);
}
__device__ __forceinline__ void rms_row(const float* xrow, const float* g, bf16* orow, int lane, f32x4 (&y)[4]) { f32x4 g4[4]; gain_load(g, lane, g4); rms_load(xrow, lane, y); rms_norm(g4, lane, y); row_store_bf16(orow, lane, y); }

constexpr float G1_WSC = 32.0f;
__device__ __forceinline__ void phase_prologue(const Frame& F, InPtrs in, const float* xres, int l) {
    unsigned char* ws = F.ws; int rot = 0;
    { const float* W = in[3] + (size_t)l * DM * DIN; LAS unsigned* scr = (LAS unsigned*)(F.lds + F.wave * 16384);
      const int nblk = (DIN + 63) / 64, nitems = (DM / 64) * nblk;
      for (int it = F.gw; it < nitems; it += NGW) { const int n0 = 64 * (it % nblk);
          if (n0 < 3072 || (n0 >= 6144 && n0 < 6728)) transpose_item(W, DM, DIN, (bf16*)(ws + WS_WIN), MapWinP{}, scr, it, F.lane);
          if (n0 >= 3072 && (n0 < 6144 || n0 + 64 > 6728)) transpose_item8(W, DM, DIN, ws + WS_WIN8, MapWin{}, G1_WSC, it, F.lane); }
      rot = nitems % NGW; }
    transpose_matrix(F, in[8] + (size_t)l * DM * 2048, DM, 2048, (bf16*)(ws + WS_WKV), MapOff{0}, rot);
    transpose_matrix(F, in[11] + (size_t)l * DM * DM, DM, DM, (bf16*)(ws + WS_WBR), MapOff{0}, rot);
    transpose_matrix8(F, in[12] + (size_t)l * DM * DM, DM, DM, ws + WS_WBR8, MapOff{0}, 32.0f, rot);
    transpose_matrix8(F, in[13] + (size_t)l * DM * DM, DM, DM, ws + WS_WBR8 + (size_t)DM * DM, MapOff{0}, 32.0f, rot);
    transpose_matrix(F, in[14] + (size_t)l * DM * DM, DM, DM, (bf16*)(ws + WS_WOUT), MapOff{0}, rot);
    for (int it = (F.gw + NGW - (rot + NBATCH * NMEM) % NGW) % NGW; it < 184; it += NGW) { GAS v4u* p = (GAS v4u*)((bf16*)(ws + WS_WIN) + (size_t)(6728 + it) * DM); p[F.lane] = (v4u){0u, 0u, 0u, 0u}; p[64 + F.lane] = (v4u){0u, 0u, 0u, 0u}; }
    f32x4 y[4];
    for (int it = (F.gw + NGW - rot) % NGW; it < NBATCH * NMEM; it += NGW) rms_row(in[1] + (size_t)it * DM, in[7] + (size_t)l * DM, (bf16*)(ws + WS_MEMN) + (size_t)it * DM, F.lane, y);
    { f32x4 g4[4]; gain_load(in[2] + (size_t)l * DM, F.lane, g4);
      f32x4 ya[4][4], yb[4][4]; const int i0 = F.gw;
#define PRO_LD4(Y, base) do { _Pragma("unroll") for (int q = 0; q < 4; ++q) rms_load(xres + (size_t)((base) + q * NGW) * DM, F.lane, Y[q]); } while (0)
#define PRO_PR4(Y, base) do { _Pragma("unroll") for (int q = 0; q < 4; ++q) { const size_t r_ = (size_t)((base) + q * NGW); rms_norm(g4, F.lane, Y[q]); \
          row_store_bf16((bf16*)(ws + WS_HB) + r_ * DM, F.lane, Y[q]); row_store_fp8(ws + WS_HB8 + r_ * DM, F.lane, Y[q]); } } while (0)
      static_assert(TOK / NGW == 16, "prologue row batches");
      PRO_LD4(ya, i0); PRO_LD4(yb, i0 + 4 * NGW); PRO_PR4(ya, i0); PRO_LD4(ya, i0 + 8 * NGW); PRO_PR4(yb, i0 + 4 * NGW); PRO_LD4(yb, i0 + 12 * NGW); PRO_PR4(ya, i0 + 8 * NGW); PRO_PR4(yb, i0 + 12 * NGW);
#undef PRO_LD4
#undef PRO_PR4
    }
    if (l == 0) {
        float2* ta = (float2*)(ws + WS_ROPEA); float2* ti = (float2*)(ws + WS_ROPEI);
        const double L2T = 13.287712379549449;
        const double inva = exp2(-(double)F.lane * (L2T / 64.0)) * 0.15915494309189535;
        const double invi = exp2(-(double)(F.lane & 31) * (L2T / 32.0)) * 0.15915494309189535;
        for (int t = F.gw; t < SEQ; t += NGW) {
            double ra = (double)t * inva; ra -= floor(ra); const float fa = (float)ra;
            ta[(size_t)t * 64 + F.lane] = make_float2(__builtin_amdgcn_cosf(fa), __builtin_amdgcn_sinf(fa));
            double ri = (double)t * invi; ri -= floor(ri); const float fi = (float)ri;
            if (F.lane < 32) ti[(size_t)t * 32 + F.lane] = make_float2(__builtin_amdgcn_cosf(fi), __builtin_amdgcn_sinf(fi));
        }
    }
}

constexpr float MOE_WSC = 64.0f, MOE_HSC = 8.0f;
__device__ __forceinline__ void phase_ffn_weights(const Frame& F, InPtrs in, int l) {
    unsigned char* ws = F.ws; int rot = 0;
    if (l == 0) {
        bf16* gu = (bf16*)(ws + WS_WFF); bf16* dn = (bf16*)(ws + WS_WFF + WFF_DOWN);
        transpose_matrix8(F, in[16], DM, DFF, (unsigned char*)gu, MapGU{0}, MOE_WSC, rot);
        transpose_matrix8(F, in[17], DM, DFF, (unsigned char*)gu, MapGU{1}, MOE_WSC, rot);
        transpose_matrix8(F, in[18], DFF, DM, (unsigned char*)dn, MapOff{0}, MOE_WSC, rot);
    } else {
        for (int e = 0; e < NEXP; ++e) {
            unsigned char* gu = ws + WS_WFF + (size_t)e * WFF_EXP; unsigned char* dn = ws + WS_WFF + (size_t)e * WFF_EXP + WFF_DOWN;
            transpose_matrix8(F, in[20] + (size_t)e * DM * DFF, DM, DFF, gu, MapGU{0}, MOE_WSC, rot);
            transpose_matrix8(F, in[21] + (size_t)e * DM * DFF, DM, DFF, gu, MapGU{1}, MOE_WSC, rot);
            transpose_matrix8(F, in[22] + (size_t)e * DFF * DM, DFF, DM, dn, MapOff{0}, MOE_WSC, rot);
        }
    }
}

struct PostConst { f32x4 cw[3][2][2]; f32x4 gq1, gq2, gk1, gk2, g4; };
struct PostRowC { v4u pa[3][2]; v4u cb[2]; };
struct PostRow { f32x4 ra0, ra1, ri0, ri1; unsigned qk[2][2][2]; v2u qi[2], ki[2]; unsigned qm[4]; };
__device__ __forceinline__ void post_const(PostConst& C, int lane, const float* convw, const float* gq, const float* gk, const float* gmq) {
    const int c0 = lane * 16, s4 = (lane & 15) * 4;
#pragma unroll
    for (int j = 0; j < 3; ++j)
#pragma unroll
        for (int hv = 0; hv < 2; ++hv) { C.cw[j][hv][0] = *(const GAS f32x4*)(convw + j * 1024 + c0 + hv * 8); C.cw[j][hv][1] = *(const GAS f32x4*)(convw + j * 1024 + c0 + hv * 8 + 4); }
    C.gq1 = *(const GAS f32x4*)(gq + s4); C.gq2 = *(const GAS f32x4*)(gq + 64 + s4); C.gk1 = *(const GAS f32x4*)(gk + s4); C.gk2 = *(const GAS f32x4*)(gk + 64 + s4);
    C.g4 = *(const GAS f32x4*)(gmq + 4 * lane);
}
__device__ __forceinline__ void post_load_conv(PostRowC& R, const bf16* BIG, int t, int lane) {
    const bf16* r0 = BIG + (size_t)t * LDB; const int c0 = lane * 16;
#pragma unroll
    for (int j = 0; j < 3; ++j) { const int tt = t - 2 + j;
#pragma unroll
        for (int hv = 0; hv < 2; ++hv) R.pa[j][hv] = tt >= 0 ? *(const GAS v4u*)(BIG + (size_t)tt * LDB + C_CC + ((c0 >> 7) << 8) + (c0 & 127) + hv * 8) : (v4u){0u, 0u, 0u, 0u}; }
#pragma unroll
    for (int hv = 0; hv < 2; ++hv) R.cb[hv] = *(const GAS v4u*)(r0 + C_CB + c0 + hv * 8);
}
__device__ __forceinline__ void post_load(PostRow& R, const bf16* BIG, int t, int lane, const float2* ropeA, const float2* ropeI) {
    const bf16* r0 = BIG + (size_t)t * LDB;
    { const int s4 = (lane & 15) * 4, hq = lane >> 4;
      R.ra0 = *(const GAS f32x4*)((const float*)ropeA + ((size_t)t * 64 + s4) * 2); R.ra1 = *(const GAS f32x4*)((const float*)ropeA + ((size_t)t * 64 + s4) * 2 + 4);
#pragma unroll
      for (int which = 0; which < 2; ++which)
#pragma unroll
          for (int it = 0; it < 2; ++it) {
              const int H_ = it * 4 + hq; const GAS unsigned char* f8in = (const GAS unsigned char*)r0 + 512 * (((which ? C_K : C_Q) >> 8) + (H_ >> 1)) + (H_ & 1) * 128 + s4;
              R.qk[which][it][0] = *(const GAS unsigned*)f8in; R.qk[which][it][1] = *(const GAS unsigned*)(f8in + 64); } }
    { const int s4 = (lane & 7) * 4, hi8 = lane >> 3;
      R.ri0 = *(const GAS f32x4*)((const float*)ropeI + ((size_t)t * 32 + s4) * 2); R.ri1 = *(const GAS f32x4*)((const float*)ropeI + ((size_t)t * 32 + s4) * 2 + 4);
      R.qi[0] = *(const GAS v2u*)(r0 + C_QI + hi8 * IDIM + s4); R.qi[1] = *(const GAS v2u*)(r0 + C_QI + hi8 * IDIM + s4 + 32);
      if (lane < 8) { R.ki[0] = *(const GAS v2u*)(r0 + C_KI + s4); R.ki[1] = *(const GAS v2u*)(r0 + C_KI + s4 + 32); } else { R.ki[0] = (v2u){0u, 0u}; R.ki[1] = (v2u){0u, 0u}; } }
#pragma unroll
    for (int hm = 0; hm < NMH; ++hm) R.qm[hm] = *((const GAS unsigned*)((const GAS unsigned char*)r0 + 512 * ((C_QM >> 8) + hm)) + lane);
}
__device__ __forceinline__ void post_compute_conv(const PostRowC& R, const PostConst& C, bf16* BIG, int t, int lane) {
    bf16* w0 = BIG + (size_t)t * LDB;
    const int c0 = lane * 16;
    float acc[16];
#pragma unroll
    for (int i = 0; i < 16; ++i) acc[i] = 0.f;
#pragma unroll
    for (int j = 0; j < 3; ++j)
#pragma unroll
        for (int hv = 0; hv < 2; ++hv) { const v4u a = R.pa[j][hv]; const f32x4 w0_ = C.cw[j][hv][0], w1_ = C.cw[j][hv][1];
            acc[hv * 8 + 0] += w0_.x * bflo(a.x); acc[hv * 8 + 1] += w0_.y * bfhi(a.x);
            acc[hv * 8 + 2] += w0_.z * bflo(a.y); acc[hv * 8 + 3] += w0_.w * bfhi(a.y);
            acc[hv * 8 + 4] += w1_.x * bflo(a.z); acc[hv * 8 + 5] += w1_.y * bfhi(a.z);
            acc[hv * 8 + 6] += w1_.z * bflo(a.w); acc[hv * 8 + 7] += w1_.w * bfhi(a.w); }
#pragma unroll
    for (int hv = 0; hv < 2; ++hv) {
        const v4u cb = R.cb[hv]; v4u o;
        o.x = pk2(bflo(cb.x) * acc[hv * 8 + 0], bfhi(cb.x) * acc[hv * 8 + 1]); o.y = pk2(bflo(cb.y) * acc[hv * 8 + 2], bfhi(cb.y) * acc[hv * 8 + 3]);
        o.z = pk2(bflo(cb.z) * acc[hv * 8 + 4], bfhi(cb.z) * acc[hv * 8 + 5]); o.w = pk2(bflo(cb.w) * acc[hv * 8 + 6], bfhi(cb.w) * acc[hv * 8 + 7]);
        *(GAS v4u*)(w0 + C_CB + c0 + hv * 8) = o;
    }
}
__device__ __forceinline__ void post_compute(const PostRow& R, const PostConst& C, bf16* BIG, int t, int lane, float* rsum) {
    bf16* w0 = BIG + (size_t)t * LDB;
    {
        const int s4 = (lane & 15) * 4, hq = lane >> 4;
        const float cs_[4] = {R.ra0.x, R.ra0.z, R.ra1.x, R.ra1.z}, sn_[4] = {R.ra0.y, R.ra0.w, R.ra1.y, R.ra1.w};
        const float qscale = 0.08838834764831845f * LOG2E;
#pragma unroll
        for (int which = 0; which < 2; ++which) {
            const int cbase = which ? C_K : C_Q; const float osc = which ? 1.0f : qscale;
            const f32x4 g1 = which ? C.gk1 : C.gq1, g2 = which ? C.gk2 : C.gq2;
#pragma unroll
            for (int it = 0; it < 2; ++it) {
                float x1[4], x2[4]; unpk4_fp8(R.qk[which][it][0], x1); unpk4_fp8(R.qk[which][it][1], x2);
                float ss = 0.f;
#pragma unroll
                for (int j = 0; j < 4; ++j) ss += x1[j] * x1[j] + x2[j] * x2[j];
#pragma unroll
                for (int o = 1; o < 16; o <<= 1) ss += shfl_xor_l(ss, o, lane);
                const float rr = osc / sqrtf(ss * (1.0f / 128.0f) + EPS);
                float o1[4], o2[4];
#pragma unroll
                for (int j = 0; j < 4; ++j) { const float y1 = x1[j] * rr * g1[j], y2 = x2[j] * rr * g2[j]; o1[j] = y1 * cs_[j] - y2 * sn_[j]; o2[j] = y2 * cs_[j] + y1 * sn_[j]; }
                GAS unsigned char* f8 = (GAS unsigned char*)(w0 + cbase + (it * 4 + hq) * HD) + (which ? 0 : 128) + s4;
                *(GAS unsigned*)f8 = cvt4_fp8(o1[0], o1[1], o1[2], o1[3]); *(GAS unsigned*)(f8 + 64) = cvt4_fp8(o2[0], o2[1], o2[2], o2[3]);
            }
        }
    }
    {
        const int s4 = (lane & 7) * 4, hi8 = lane >> 3;
        const float cs_[4] = {R.ri0.x, R.ri0.z, R.ri1.x, R.ri1.z}, sn_[4] = {R.ri0.y, R.ri0.w, R.ri1.y, R.ri1.w};
#pragma unroll
        for (int which = 0; which < 2; ++which) {
            if (which == 1 && lane >= 8) break;
            const int off = which ? C_KI + s4 : C_QI + hi8 * IDIM + s4;
            const v2u a = which ? R.ki[0] : R.qi[0], bq = which ? R.ki[1] : R.qi[1];
            const float x1[4] = {bflo(a.x), bfhi(a.x), bflo(a.y), bfhi(a.y)}, x2[4] = {bflo(bq.x), bfhi(bq.x), bflo(bq.y), bfhi(bq.y)};
            float o1[4], o2[4];
#pragma unroll
            for (int j = 0; j < 4; ++j) { o1[j] = x1[j] * cs_[j] - x2[j] * sn_[j]; o2[j] = x2[j] * cs_[j] + x1[j] * sn_[j]; }
            v2u w1, w2; w1.x = pk2(o1[0], o1[1]); w1.y = pk2(o1[2], o1[3]); w2.x = pk2(o2[0], o2[1]); w2.y = pk2(o2[2], o2[3]);
            *(GAS v2u*)(w0 + off) = w1; *(GAS v2u*)(w0 + off + 32) = w2;
        }
    }
    {
        const f32x4 g4 = C.g4; const float ms = 0.0625f * LOG2E;
#pragma unroll
        for (int hm = 0; hm < NMH; ++hm) { GAS v2u* pw = (GAS v2u*)(w0 + C_QM + hm * MHD) + lane; float xq_[4]; unpk4_fp8(R.qm[hm], xq_);
            const float x0 = xq_[0], x1 = xq_[1], x2 = xq_[2], x3 = xq_[3];
            const float rr = ms / sqrtf(wave_sum((x0 * x0 + x1 * x1) + (x2 * x2 + x3 * x3), lane) * (1.0f / 256.0f) + EPS);
            v2u o; o.x = pk2(x0 * rr * g4.x, x1 * rr * g4.y); o.y = pk2(x2 * rr * g4.z, x3 * rr * g4.w); *pw = o; }
    }
    if (lane < 4) rsum[(size_t)t * 4 + lane] = 0.f;
}
__device__ __forceinline__ void vt_item(const bf16* BIG, unsigned char* VT8, LAS unsigned char* scr, int item, int lane) {
    const int h = item & 7, k0 = (item >> 3) * 64;
    const GAS unsigned char* src = (const GAS unsigned char*)BIG + 512 * ((C_V >> 8) + (h >> 1)) + (h & 1) * 128;
#pragma unroll
    for (int i = 0; i < 8; ++i) { const int row = 8 * i + (lane >> 3), ch = lane & 7;
        const v4u v = *(const GAS v4u*)(src + (size_t)(k0 + row) * (LDB * 2) + ch * 16);
        *(LAS v4u*)(scr + row * 128 + ((ch ^ (row & 7)) << 4)) = v; }
    LDS_WAIT(); asm volatile("" ::: "memory");
#pragma unroll 2
    for (int it = 0; it < 8; ++it) { const int id = it * 64 + lane, d = id >> 2, ch = id & 3; unsigned e[16];
#pragma unroll
        for (int i = 0; i < 16; ++i) { const int key = 32 * (ch & 1) + 8 * (i >> 2) + 4 * (ch >> 1) + (i & 3);
            e[i] = *(const LAS unsigned char*)(scr + key * 128 + ((((d >> 4) ^ (key & 7))) << 4) + (d & 15)); }
        v4u o; o.x = e[0] | (e[1] << 8) | (e[2] << 16) | (e[3] << 24); o.y = e[4] | (e[5] << 8) | (e[6] << 16) | (e[7] << 24);
        o.z = e[8] | (e[9] << 8) | (e[10] << 16) | (e[11] << 24); o.w = e[12] | (e[13] << 8) | (e[14] << 16) | (e[15] << 24);
        *(GAS v4u*)(VT8 + ((size_t)h * HD + d) * SEQ + k0 + ch * 16) = o; }
    LDS_WAIT(); asm volatile("" ::: "memory");
}
__device__ __forceinline__ void mem_post(const Frame& F, const float* gmk) {
    const bf16* kv = (const bf16*)(F.ws + WS_MEMKV); bf16* mkn = (bf16*)(F.ws + WS_MKN); bf16* mvt = (bf16*)(F.ws + WS_MVT);
    const int lane = F.lane;
    for (int it = F.gw; it < NBATCH * NMEM * NMH; it += NGW) { const int hm = it & 3, bm = it >> 2, b = bm >> 8, m = bm & 255;
        const v2u w = *((const GAS v2u*)(kv + (size_t)bm * 2048 + hm * MHD) + lane); const f32x4 g4 = *(const GAS f32x4*)(gmk + 4 * lane);
        const float x0 = bflo(w.x), x1 = bfhi(w.x), x2 = bflo(w.y), x3 = bfhi(w.y);
        const float rr = 1.0f / sqrtf(wave_sum((x0 * x0 + x1 * x1) + (x2 * x2 + x3 * x3), lane) * (1.0f / 256.0f) + EPS);
        v2u o; o.x = pk2(x0 * rr * g4.x, x1 * rr * g4.y); o.y = pk2(x2 * rr * g4.z, x3 * rr * g4.w);
        *((GAS v2u*)(mkn + ((size_t)b * 1024 + hm * 256 + m) * 256) + lane) = o; }
#pragma unroll
    for (int u = 0; u < (NBATCH * NMEM * 16) / NGW; ++u) { const int pr = F.gw + u * NGW, it = pr >> 4, j = pr & 15, b = it >> 8, m = it & 255;
        const int idx = j * 64 + lane; mvt[((size_t)b * 1024 + idx) * 256 + m] = kv[(size_t)it * 2048 + 1024 + idx]; }
}
__device__ __forceinline__ void phase_post(const Frame& F, InPtrs in, int l, int b) {
    bf16* BIG = (bf16*)(F.ws + WS_BIG);
    const float* convw = in[4] + (size_t)l * 3 * 1024; const float* gq = in[5] + l * HD; const float* gk = in[6] + l * HD; const float* gmq = in[9] + l * MHD;
    { const float2* ropeA = (const float2*)(F.ws + WS_ROPEA); const float2* ropeI = (const float2*)(F.ws + WS_ROPEI); float* rsum = (float*)(F.ws + WS_RSUM);
      PostConst C; post_const(C, F.lane, convw, gq, gk, gmq);
      { const int tb = F.gw * (SEQ / NGW), c0 = F.lane * 16; const int pcol = C_CC + ((c0 >> 7) << 8) + (c0 & 127);
        v4u pm2[2], pm1[2], pa_[2], pb_[2], cba[2], cbb[2];
#pragma unroll
        for (int hv = 0; hv < 2; ++hv) {
            pm2[hv] = tb >= 2 ? *(const GAS v4u*)(BIG + (size_t)(tb - 2) * LDB + pcol + hv * 8) : (v4u){0u, 0u, 0u, 0u};
            pm1[hv] = tb >= 1 ? *(const GAS v4u*)(BIG + (size_t)(tb - 1) * LDB + pcol + hv * 8) : (v4u){0u, 0u, 0u, 0u};
            pa_[hv] = *(const GAS v4u*)(BIG + (size_t)tb * LDB + pcol + hv * 8); cba[hv] = *(const GAS v4u*)(BIG + (size_t)tb * LDB + C_CB + c0 + hv * 8); }
#pragma unroll
        for (int k = 0; k < SEQ / NGW; k += 2) { const int t = tb + k;
#pragma unroll
            for (int hv = 0; hv < 2; ++hv) { pb_[hv] = *(const GAS v4u*)(BIG + (size_t)(t + 1) * LDB + pcol + hv * 8); cbb[hv] = *(const GAS v4u*)(BIG + (size_t)(t + 1) * LDB + C_CB + c0 + hv * 8); }
            { PostRowC R; for (int hv = 0; hv < 2; ++hv) { R.pa[0][hv] = pm2[hv]; R.pa[1][hv] = pm1[hv]; R.pa[2][hv] = pa_[hv]; R.cb[hv] = cba[hv]; } post_compute_conv(R, C, BIG, t, F.lane); }
            if (k + 2 < SEQ / NGW) {
#pragma unroll
                for (int hv = 0; hv < 2; ++hv) { cba[hv] = *(const GAS v4u*)(BIG + (size_t)(t + 2) * LDB + C_CB + c0 + hv * 8); pm2[hv] = *(const GAS v4u*)(BIG + (size_t)(t + 2) * LDB + pcol + hv * 8); } }
            { PostRowC R; for (int hv = 0; hv < 2; ++hv) { R.pa[0][hv] = pm1[hv]; R.pa[1][hv] = pa_[hv]; R.pa[2][hv] = pb_[hv]; R.cb[hv] = cbb[hv]; } post_compute_conv(R, C, BIG, t + 1, F.lane); }
#pragma unroll
            for (int hv = 0; hv < 2; ++hv) { pm1[hv] = pb_[hv]; const v4u nx = pm2[hv]; pm2[hv] = pa_[hv]; pa_[hv] = nx; } } }
      { PostRow Ra, Rb; const int tb = F.gw * (SEQ / NGW);
        post_load(Ra, BIG, tb, F.lane, ropeA, ropeI);
        for (int k = 0; k < SEQ / NGW; k += 2) { const int t = tb + k;
            post_load(Rb, BIG, t + 1, F.lane, ropeA, ropeI); post_compute(Ra, C, BIG, t, F.lane, rsum);
            if (k + 2 < SEQ / NGW) post_load(Ra, BIG, t + 2, F.lane, ropeA, ropeI);
            post_compute(Rb, C, BIG, t + 1, F.lane, rsum); } } }
    LAS unsigned char* scr = F.lds + F.wave * 16384;
    for (int it = F.gw; it < (SEQ / 64) * NH; it += NGW) vt_item(BIG, F.ws + WS_VT, scr, it, F.lane);
    if (b == 0) mem_post(F, in[10] + l * MHD);
}

constexpr int IDX_CAP = 958, IDX_PITCH = IDX_CAP + 1, IDX_WOFF = 32 * IDX_PITCH * 4;
static_assert(IDX_WOFF + 32 * 256 * 4 <= RING_BYTES, "indexer LDS");
__device__ __forceinline__ unsigned idx_pack(float sc, int key) { const unsigned b = __builtin_bit_cast(unsigned, sc); const unsigned k = b ^ ((unsigned)((int)b >> 31) | 0x80000000u); return (k & 0xFFFFC000u) | (16383u - (unsigned)key); }
__device__ __forceinline__ unsigned idx_packi(float sc, unsigned inv) { const unsigned b = __builtin_bit_cast(unsigned, sc); const unsigned k = b ^ ((unsigned)((int)b >> 31) | 0x80000000u); return (k & 0xFFFFC000u) | inv; }
__device__ __forceinline__ float idx_tau(unsigned v) { const unsigned k = v & 0xFFFFC000u; const unsigned bits = (k & 0x80000000u) ? (k ^ 0x80000000u) : ~k; return __builtin_bit_cast(float, bits); }
__device__ __forceinline__ int wave_sum4(int v) {
    return __popcll(__ballot(v & 1)) + 2 * __popcll(__ballot(v & 2)) + 4 * __popcll(__ballot(v & 4)) + 8 * __popcll(__ballot(v & 8));
}
template <bool EXACT> __device__ __forceinline__ void prune_list(LAS unsigned* lst, LAS unsigned* cntp, LAS float* taup, LAS unsigned* trash, int lane) {
    const int n = __builtin_amdgcn_readfirstlane((int)*cntp);
    unsigned e[(IDX_CAP + 63) / 64];
#pragma unroll
    for (int j = 0; j < (IDX_CAP + 63) / 64; ++j) { const int idx = lane + 64 * j; e[j] = idx < n ? lst[idx] : 0u; }
    unsigned mn = 0xFFFFFFFFu, mx = 0u;
#pragma unroll
    for (int j = 0; j < (IDX_CAP + 63) / 64; ++j) { mx = e[j] > mx ? e[j] : mx; mn = (e[j] != 0u && e[j] < mn) ? e[j] : mn; }
#pragma unroll
    for (int o = 1; o < 64; o <<= 1) { const unsigned a = (unsigned)__builtin_amdgcn_ds_bpermute((lane ^ o) << 2, (int)mx), b = (unsigned)__builtin_amdgcn_ds_bpermute((lane ^ o) << 2, (int)mn); mx = a > mx ? a : mx; mn = b < mn ? b : mn; }
    unsigned lo = mn, hi = mx + 1u, prefix = mn; int clo = n, chi = 0; bool elem = false;
#pragma unroll 1
    for (int iter = 0; iter < 4096; ++iter) {
        unsigned cand = 0u; const unsigned span = hi - lo - 1u;
#pragma unroll
        for (int j = 0; j < (IDX_CAP + 63) / 64; ++j) cand = ((e[j] - lo - 1u) < span) ? e[j] : cand;
        const unsigned long long m = __ballot(cand != 0u);
        if (m == 0ull) { prefix = lo; break; }
        const int src = (int)__builtin_ctzll(m);
        unsigned pv = (unsigned)__builtin_amdgcn_readlane((int)cand, src);
        if (!elem) { const float f = (float)((EXACT ? TOPK : TOPK + 32) - chi) / (float)(clo - chi);
            const unsigned gap = hi - lo; unsigned off = (unsigned)((float)gap * (1.0f - f)); off = off < 1u ? 1u : (off >= gap ? gap - 1u : off); pv = lo + off; }
        int cl = 0;
#pragma unroll
        for (int j = 0; j < (IDX_CAP + 63) / 64; ++j) cl += (e[j] >= pv) ? 1 : 0;
        const int c = wave_sum4(cl);
        elem = !elem && (c == clo || c == chi);
        if (c >= TOPK) { lo = pv; clo = c; prefix = pv; if (c == TOPK || (!EXACT && c <= TOPK + 64)) break; }
        else { hi = pv; chi = c; }
    }
    int kl = 0;
#pragma unroll
    for (int j = 0; j < (IDX_CAP + 63) / 64; ++j) kl += (e[j] >= prefix) ? 1 : 0;
    const unsigned long long m0 = __ballot(kl & 1), m1 = __ballot(kl & 2), m2 = __ballot(kl & 4), m3 = __ballot(kl & 8);
    const int total = __popcll(m0) + 2 * __popcll(m1) + 4 * __popcll(m2) + 8 * __popcll(m3);
#define IDX_MBC(mm) ((int)__builtin_amdgcn_mbcnt_hi((unsigned)((mm) >> 32), __builtin_amdgcn_mbcnt_lo((unsigned)(mm), 0u)))
    int pos = IDX_MBC(m0) + 2 * IDX_MBC(m1) + 4 * IDX_MBC(m2) + 8 * IDX_MBC(m3);
#undef IDX_MBC
#pragma unroll
    for (int j = 0; j < (IDX_CAP + 63) / 64; ++j) { const bool keep = e[j] >= prefix; LAS unsigned* dst = keep ? lst + pos : trash; *dst = e[j]; pos += keep ? 1 : 0; }
    if (lane == 0) { *cntp = (unsigned)total; *taup = idx_tau(prefix); }
}
__device__ __forceinline__ void indexer_group(const Frame& F, const bf16* BIG, unsigned* MASKQ, int g) {
    LAS unsigned* list = (LAS unsigned*)F.lds; LAS unsigned* wq = (LAS unsigned*)(F.lds + IDX_WOFF);
    LAS unsigned* cnt = (LAS unsigned*)(F.lds + LDSCTL_OFF); LAS float* tau = (LAS float*)(F.lds + LDSCTL_OFF + 128);
    const int lane = F.lane, wave = F.wave, c = lane & 31, hi = lane >> 5, t = 32 * g + c;
#define IDX_LOADK(dst, kb_) do { const bf16* krow_ = BIG + (size_t)(32 * (kb_) + c) * LDB + C_KI + hi * 8; _Pragma("unroll") for (int ks = 0; ks < 4; ++ks) dst[ks] = *(const GAS bf16x8*)(krow_ + ks * 16); } while (0)
    bf16x8 ka[4], kn[4];
    if (wave <= g) IDX_LOADK(ka, wave);
    if (F.tid < 32) { cnt[F.tid] = 0u; tau[F.tid] = -__builtin_inff(); }
    { const int q = F.tid >> 4; const bf16* qrow = BIG + (size_t)(32 * g + q) * LDB + C_QI;
#pragma unroll
      for (int i = 0; i < 4; ++i) { const int ch = (F.tid & 15) * 4 + i; const v4u v = *(const GAS v4u*)(qrow + ch * 8); *(LAS v4u*)((LAS unsigned char*)wq + q * 1024 + ((ch ^ (q & 15)) << 4)) = v; } }
    const LAS unsigned char* qlds = (const LAS unsigned char*)wq + c * 1024;
    float w[NIH];
    { const v4u ww = *(const GAS v4u*)(BIG + (size_t)t * LDB + C_WI); const float wscale = 0.04419417382415922f;
      w[0] = bflo(ww.x) * wscale; w[1] = bfhi(ww.x) * wscale; w[2] = bflo(ww.y) * wscale; w[3] = bfhi(ww.y) * wscale;
      w[4] = bflo(ww.z) * wscale; w[5] = bfhi(ww.z) * wscale; w[6] = bflo(ww.w) * wscale; w[7] = bfhi(ww.w) * wscale; }
    LAS float* wl = (LAS float*)(F.lds + LDSCTL_OFF + 256);
    LAS unsigned* trash = (LAS unsigned*)(F.lds + LDSCTL_OFF + 4096) + wave * 64 + lane;
    if (hi == 0) {
#pragma unroll
        for (int h = 0; h < NIH; ++h) wl[c * 8 + h] = 0.5f * w[h]; }
    __syncthreads();
    const int nkt = (g >> 3) + 1;
    int qo0[4], qo1[4];
#pragma unroll
    for (int ks = 0; ks < 4; ++ks) { qo0[ks] = ((ks * 2 + hi) ^ (c & 15)) << 4; qo1[ks] = ((8 + ks * 2 + hi) ^ (c & 15)) << 4; }
    bf16x8 qs[4];
#pragma unroll
    for (int ks = 0; ks < 4; ++ks) { float a8[8];
#pragma unroll
        for (int j = 0; j < 8; ++j) a8[j] = 0.f;
#pragma unroll
        for (int h = 0; h < NIH; ++h) { const v4u f = *(const LAS v4u*)(qlds + (h >> 1) * 256 + ((h & 1) ? qo1[ks] : qo0[ks])); const float wh = 0.5f * w[h];
            a8[0] = fmaf(bflo(f.x), wh, a8[0]); a8[1] = fmaf(bfhi(f.x), wh, a8[1]); a8[2] = fmaf(bflo(f.y), wh, a8[2]); a8[3] = fmaf(bfhi(f.y), wh, a8[3]);
            a8[4] = fmaf(bflo(f.z), wh, a8[4]); a8[5] = fmaf(bfhi(f.z), wh, a8[5]); a8[6] = fmaf(bflo(f.w), wh, a8[6]); a8[7] = fmaf(bfhi(f.w), wh, a8[7]); }
        v4u o; o.x = cvt_pk_bf16(a8[0], a8[1]); o.y = cvt_pk_bf16(a8[2], a8[3]); o.z = cvt_pk_bf16(a8[4], a8[5]); o.w = cvt_pk_bf16(a8[6], a8[7]); qs[ks] = __builtin_bit_cast(bf16x8, o); }
#define IDX_RELU_FMA(accv, wv) do { _Pragma("unroll") for (int r = 0; r < 16; ++r) asm("v_fma_f32 %0, |%1|, %2, %0" : "+v"(sc[r]) : "v"(accv[r]), "v"(wv)); } while (0)
    asm volatile("" : "+v"(ka[0]), "+v"(ka[1]), "+v"(ka[2]), "+v"(ka[3]));
    for (int kt = 0; kt < nkt; ++kt) {
        const int kb = 8 * kt + wave;
        if (kb <= g) {
            if (kb + 8 <= g) IDX_LOADK(kn, kb + 8);
            const float tauc = tau[c];
            f32x16 sc, accA, accB;
#pragma unroll
            for (int r = 0; r < 16; ++r) sc[r] = 0.f;
#pragma unroll
            for (int ks = 0; ks < 4; ++ks) sc = __builtin_amdgcn_mfma_f32_32x32x16_bf16(ka[ks], qs[ks], sc, 0, 0, 0);
            bf16x8 bA[4], bB[4]; float wprev = 0.f;
#pragma unroll
            for (int ks = 0; ks < 4; ++ks) bA[ks] = *(const LAS bf16x8*)(qlds + qo0[ks]);
#pragma unroll 1
            for (int hp = 0; hp < 4; ++hp) {
                const LAS unsigned char* qh = qlds + hp * 256;
                const float wA = wl[c * 8 + 2 * hp], wB = wl[c * 8 + 2 * hp + 1];
#pragma unroll
                for (int r = 0; r < 16; ++r) accA[r] = 0.f;
#pragma unroll
                for (int ks = 0; ks < 4; ++ks) accA = __builtin_amdgcn_mfma_f32_32x32x16_bf16(ka[ks], bA[ks], accA, 0, 0, 0);
#pragma unroll
                for (int ks = 0; ks < 4; ++ks) bB[ks] = *(const LAS bf16x8*)(qh + qo1[ks]);
                if (hp > 0) IDX_RELU_FMA(accB, wprev);
#pragma unroll
                for (int r = 0; r < 16; ++r) accB[r] = 0.f;
#pragma unroll
                for (int ks = 0; ks < 4; ++ks) accB = __builtin_amdgcn_mfma_f32_32x32x16_bf16(ka[ks], bB[ks], accB, 0, 0, 0);
                if (hp < 3) {
#pragma unroll
                    for (int ks = 0; ks < 4; ++ks) bA[ks] = *(const LAS bf16x8*)(qh + 256 + qo0[ks]);
                }
                IDX_RELU_FMA(accA, wA);
                wprev = wB;
            }
            IDX_RELU_FMA(accB, wprev);
            const int kbase = 32 * kb + 4 * hi; const unsigned ibase = 16383u - (unsigned)kbase;
            if (kb == g) {
#pragma unroll
                for (int r = 0; r < 16; ++r) sc[r] = (kbase + (r & 3) + 8 * (r >> 2) <= t) ? sc[r] : __builtin_nanf("");
            }
            int npass = 0;
#pragma unroll
            for (int r = 0; r < 16; ++r) npass += (sc[r] >= tauc) ? 1 : 0;
            int pos = (int)__hip_atomic_fetch_add(cnt + c, (unsigned)npass, __ATOMIC_RELAXED, __HIP_MEMORY_SCOPE_WORKGROUP);
            LAS unsigned* lrow = list + c * IDX_PITCH;
#pragma unroll
            for (int r = 0; r < 16; ++r) { const bool ok = sc[r] >= tauc;
                LAS unsigned* dst = ok ? lrow + pos : trash; *dst = idx_packi(sc[r], ibase - (unsigned)((r & 3) + 8 * (r >> 2))); pos += ok ? 1 : 0; }
#pragma unroll
            for (int ks = 0; ks < 4; ++ks) ka[ks] = kn[ks];
            asm volatile("" : "+v"(ka[0]), "+v"(ka[1]), "+v"(ka[2]), "+v"(ka[3]));
        }
        __syncthreads();
#pragma unroll 1
        for (int j = 0; j < 4; ++j) { const int q = wave * 4 + j; if (__builtin_amdgcn_readfirstlane((int)cnt[q]) > IDX_CAP - 256) prune_list<false>(list + q * IDX_PITCH, cnt + q, tau + q, trash, lane); }
        __syncthreads();
    }
#pragma unroll 1
    for (int j = 0; j < 4; ++j) { const int q = wave * 4 + j; if (__builtin_amdgcn_readfirstlane((int)cnt[q]) > TOPK) prune_list<true>(list + q * IDX_PITCH, cnt + q, tau + q, trash, lane); }
    __syncthreads();
    for (int p = 0; p < 2; ++p) {
        if (p == 1 && g < 256) break;
        { unsigned z_ = 0u; asm volatile("" : "+v"(z_));
          for (int i = F.tid; i < 2048; i += NTHREADS) ((LAS v4u*)wq)[i] = (v4u){z_, z_, z_, z_}; }
        __syncthreads();
#pragma unroll 1
        for (int j = 0; j < 4; ++j) { const int q = wave * 4 + j; const int n = __builtin_amdgcn_readfirstlane((int)cnt[q]);
            for (int idx = lane; idx < n; idx += 64) { const unsigned e = list[q * IDX_PITCH + idx]; const int s = 16383 - (int)(e & 0x3FFFu), kbb = s >> 5;
                if ((kbb >> 8) == p) __hip_atomic_fetch_or(wq + q * 256 + (kbb & 255), 1u << (s & 31), __ATOMIC_RELAXED, __HIP_MEMORY_SCOPE_WORKGROUP); } }
        __syncthreads();
        { const int q = F.tid >> 4;
#pragma unroll
          for (int jj = 0; jj < 4; ++jj) { const int wd = 4 * ((F.tid & 15) + 16 * jj);
              if (256 * p + wd <= g) *(GAS v4u*)(MASKQ + (size_t)(32 * g + q) * 512 + 256 * p + wd) = *(const LAS v4u*)(wq + q * 256 + wd); } }
        __syncthreads();
    }
}
#undef IDX_LOADK
#undef IDX_RELU_FMA
__device__ __forceinline__ void phase_indexer(const Frame& F) {
    const bf16* BIG = (const bf16*)(F.ws + WS_BIG); unsigned* MASKQ = (unsigned*)(F.ws + WS_MASK);
    for (int i = F.bid; i < 256; i += GRID) { indexer_group(F, BIG, MASKQ, 511 - i); indexer_group(F, BIG, MASKQ, i); }
}

constexpr float BR_ASC = 16.0f, BR_WSC = 32.0f;
typedef int v8i __attribute__((ext_vector_type(8)));
constexpr int ATT_STAGE = 36864, ATT_NST = 4, ATT_LUT = ATT_NST * ATT_STAGE;
static_assert(ATT_LUT + 256 <= RING_BYTES && ATT_LUT % 256 == 0, "attention LDS");
__device__ __forceinline__ void glds16s_lo(unsigned voff, const void* sbase, unsigned lds_dst) { unsigned keep;
    asm volatile("s_mov_b32 %0, m0\n\ts_mov_b32 m0, %3\n\ts_mov_b32 exec_hi, 0\n\ts_nop 0\n\tglobal_load_lds_dwordx4 %1, %2\n\ts_mov_b32 exec_hi, -1\n\ts_mov_b32 m0, %0" : "=&s"(keep) : "v"(voff), "s"(sbase), "s"(lds_dst) : "memory"); }
#define ATT_MFMA(a_, b_, c_, bfmt_) __builtin_amdgcn_mfma_scale_f32_32x32x64_f8f6f4(a_, b_, c_, 0, bfmt_, 0, 0, 0, 0)
__device__ __forceinline__ void attn_unit(const Frame& F, bf16* BIG, const unsigned char* VT8, const unsigned* MASKQ, int h, int Qb, float shift) {
    int lane; asm volatile("v_mbcnt_lo_u32_b32 %0, -1, 0\n\tv_mbcnt_hi_u32_b32 %0, -1, %0" : "=v"(lane));
    const int wave = F.wave, c = lane & 31, hi = lane >> 5, g = 8 * Qb + wave, t = 256 * Qb + 32 * wave + c, tid = wave * 64 + lane;
    const unsigned lds0 = (unsigned)(uintptr_t)F.lds;
    v8i qf[2];
    f32x16 o[4];
#pragma unroll
    for (int d = 0; d < 4; ++d)
#pragma unroll
        for (int r = 0; r < 16; ++r) o[d][r] = 0.f;
    const int ntile = 2 * Qb + 2;
#define ATT_ROW() (8 * wave + (lane >> 3))
#define ATT_KVO() ((unsigned)(ATT_ROW() * (LDB * 2) + (((lane & 7) ^ ((ATT_ROW() >> 1) & 7)) << 4)))
#define ATT_VVO() ((unsigned)(ATT_ROW() * SEQ + (((lane & 7) ^ ((ATT_ROW() >> 1) & 7)) << 4)))
#define ATT_MVO() ((unsigned)((lane & 31) * 2048))
    const unsigned char* kbase0 = (const unsigned char*)(BIG + C_K + h * HD); const unsigned char* vbase0 = VT8 + (size_t)h * HD * SEQ; const unsigned* mbase0 = MASKQ + (size_t)(256 * Qb + 32 * wave) * 512;
#define ATT_DMA_PIECE(i_, tile, stage) do { const unsigned sb_ = lds0 + (unsigned)(stage) * ATT_STAGE; \
        if ((i_) == 0) glds16s(ATT_KVO(), kbase0 + (size_t)(tile) * 128 * (LDB * 2), (unsigned)__builtin_amdgcn_readfirstlane(sb_ + wave * 1024)); \
        if ((i_) == 1) glds16s(ATT_KVO(), kbase0 + ((size_t)(tile) * 128 + 64) * (LDB * 2), (unsigned)__builtin_amdgcn_readfirstlane(sb_ + (wave + 8) * 1024)); \
        if ((i_) == 2) glds16s(ATT_VVO(), vbase0 + (tile) * 128, (unsigned)__builtin_amdgcn_readfirstlane(sb_ + 16384 + wave * 1024)); \
        if ((i_) == 3) glds16s(ATT_VVO(), vbase0 + (tile) * 128 + (size_t)64 * SEQ, (unsigned)__builtin_amdgcn_readfirstlane(sb_ + 16384 + (wave + 8) * 1024)); \
        if ((i_) == 4) glds16s_lo(ATT_MVO(), mbase0 + 4 * (tile), (unsigned)__builtin_amdgcn_readfirstlane(sb_ + 32768 + wave * 512)); } while (0)
#define ATT_DMA(tile, stage) do { ATT_DMA_PIECE(0, tile, stage); ATT_DMA_PIECE(1, tile, stage); ATT_DMA_PIECE(2, tile, stage); ATT_DMA_PIECE(3, tile, stage); ATT_DMA_PIECE(4, tile, stage); } while (0)
    const int kxh = ((c >> 1) & 7) ^ (hi << 1);
    int ka[4], va[4], mbs = 32768 + wave * 512 + c * 16;
    ka[0] = c * 128 + ((0 ^ kxh) << 4); ka[1] = c * 128 + ((1 ^ kxh) << 4); ka[2] = c * 128 + ((4 ^ kxh) << 4); ka[3] = c * 128 + ((5 ^ kxh) << 4);
#pragma unroll
    for (int i = 0; i < 4; ++i) va[i] = ka[i];
    if (tid < 16) { f32x4 e; e.x = (tid & 1) ? -shift : -__builtin_inff(); e.y = (tid & 2) ? -shift : -__builtin_inff(); e.z = (tid & 4) ? -shift : -__builtin_inff(); e.w = (tid & 8) ? -shift : -__builtin_inff();
        *(LAS f32x4*)(F.lds + ATT_LUT + tid * 16) = e; }
    ATT_DMA(0, 0); ATT_DMA((ntile > 1 ? 1 : 0), 1);
    { const GAS unsigned char* qrow = (const GAS unsigned char*)(BIG + (size_t)t * LDB + C_Q + h * HD) + 128 + hi * 32;
#pragma unroll
      for (int ks = 0; ks < 2; ++ks) { const v4u a = *(const GAS v4u*)(qrow + ks * 64), b = *(const GAS v4u*)(qrow + ks * 64 + 16);
          qf[ks] = (v8i){(int)a.x, (int)a.y, (int)a.z, (int)a.w, (int)b.x, (int)b.y, (int)b.z, (int)b.w}; } }
    asm volatile("" : "+v"(qf[0]), "+v"(qf[1]));
    const unsigned lutb = lds0 + ATT_LUT;
#define ATT_CW(w_, kb_) ({ unsigned W_ = (w_) >> (4 * hi); W_ = ((kb_) > g) ? 0u : W_; (W_ << 4) & 0xF0F0F0F0u; })
#define ATT_CQ(sv, W_, q4) do { const f32x4 e_ = *(const LAS f32x4*)(uintptr_t)(lutb | (((W_) >> (8 * (q4))) & 0xFFu)); \
        sv[4 * (q4) + 0] = e_.x; sv[4 * (q4) + 1] = e_.y; sv[4 * (q4) + 2] = e_.z; sv[4 * (q4) + 3] = e_.w; } while (0)
#define ATT_LD32(dst, a0_, a1_, off_) do { const v4u x_ = *(const LAS v4u*)(F.lds + (a0_) + (off_)), y_ = *(const LAS v4u*)(F.lds + (a1_) + (off_)); \
        dst = (v8i){(int)x_.x, (int)x_.y, (int)x_.z, (int)x_.w, (int)y_.x, (int)y_.y, (int)y_.z, (int)y_.w}; } while (0)
#define ATT_LOADK1(j_, ks_) ATT_LD32(akx, ka[2 * (ks_)], ka[2 * (ks_) + 1], (j_) * 4096)
#define ATT_LOADV1(ad_, jb_, dt_) ATT_LD32(avx, ad_[2 * (jb_)], ad_[2 * (jb_) + 1], 16384 + (dt_) * 4096)
#define ATT_SMQ(sv, pb_, dw_, g4) do { \
            const float p0_ = fast_exp2(sv[4 * (g4) + 0]), p1_ = fast_exp2(sv[4 * (g4) + 1]), p2_ = fast_exp2(sv[4 * (g4) + 2]), p3_ = fast_exp2(sv[4 * (g4) + 3]); \
            int w_ = pb_[(dw_) + (g4)]; w_ = __builtin_amdgcn_cvt_pk_bf8_f32(p0_, p1_, w_, false); w_ = __builtin_amdgcn_cvt_pk_bf8_f32(p2_, p3_, w_, true); pb_[(dw_) + (g4)] = w_; } while (0)
    f32x16 S0, S1; v8i akx, avx, pbA, pbB; v4u mw; unsigned mwn;
    f32x16 lacc; v8i ones;
#pragma unroll
    for (int r = 0; r < 16; ++r) lacc[r] = 0.f;
    { int o_ = 0x38383838; asm volatile("" : "+v"(o_)); ones = (v8i){o_, o_, o_, o_, o_, o_, o_, o_}; }
#pragma unroll
    for (int r = 0; r < 16; ++r) S1[r] = -__builtin_inff();
    { int z_ = 0; asm volatile("" : "+v"(z_));
      const v8i zz = (v8i){z_, z_, z_, z_, z_, z_, z_, z_};
      avx = zz; pbA = zz; pbB = zz; }
    int stage = 0;
    asm volatile("s_waitcnt vmcnt(5)" ::: "memory");
    mw = *(const LAS v4u*)(F.lds + mbs);
    __builtin_amdgcn_s_barrier();
    asm volatile("" ::: "memory");
    { const unsigned W0_ = ATT_CW(mw[0], 0); ATT_CQ(S0, W0_, 0); ATT_CQ(S0, W0_, 1); ATT_CQ(S0, W0_, 2); ATT_CQ(S0, W0_, 3); }
#define ATT_FENCE() __builtin_amdgcn_sched_barrier(0)
#define ATT_ORD() do { __builtin_amdgcn_sched_group_barrier(0x008, 1, 0); __builtin_amdgcn_sched_group_barrier(0x002, 20, 0); __builtin_amdgcn_sched_group_barrier(0x100, 3, 0); } while (0)
#define ATT_PIN(x_) asm volatile("" : "+v"(x_))
#define ATT_SLOT(j_, SQ, SS, PBD, DWB, PBV, DT0, VAD1, VJB1, VDT1, VAD3, VJB3, VDT3, WN, KBN, LS) do { \
        ATT_DMA_PIECE(j_, tn, sn); \
        if ((j_) == 3) ATT_DMA_PIECE(4, tn, sn); \
        if ((j_) == 2) { asm volatile("s_waitcnt vmcnt(3)" ::: "memory"); mwn = *(const LAS unsigned*)(F.lds + mbs + ((stage == 3) ? -3 * ATT_STAGE : ATT_STAGE)); } \
        ATT_FENCE(); \
        const unsigned Wn_ = ATT_CW(WN, KBN); \
        o[DT0] = ATT_MFMA(avx, PBV, o[DT0], 1); ATT_PIN(o[DT0]); ATT_SMQ(SS, PBD, DWB, 0); ATT_CQ(SS, Wn_, 0); ATT_LOADV1(VAD1, VJB1, VDT1); ATT_ORD(); \
        ATT_FENCE(); \
        SQ = ATT_MFMA(akx, qf[0], SQ, 0); ATT_PIN(SQ); ATT_SMQ(SS, PBD, DWB, 1); ATT_CQ(SS, Wn_, 1); ATT_LOADK1(j_, 1); ATT_ORD(); \
        ATT_FENCE(); \
        o[(DT0) + 1] = ATT_MFMA(avx, PBV, o[(DT0) + 1], 1); ATT_PIN(o[(DT0) + 1]); if (LS) { lacc = ATT_MFMA(ones, PBV, lacc, 1); ATT_PIN(lacc); } ATT_SMQ(SS, PBD, DWB, 2); ATT_CQ(SS, Wn_, 2); ATT_LOADV1(VAD3, VJB3, VDT3); ATT_ORD(); \
        ATT_FENCE(); \
        SQ = ATT_MFMA(akx, qf[1], SQ, 0); ATT_PIN(SQ); ATT_SMQ(SS, PBD, DWB, 3); ATT_CQ(SS, Wn_, 3); if ((j_) < 3) ATT_LOADK1((j_) + 1, 0); ATT_ORD(); \
        ATT_FENCE(); } while (0)
    for (int tile = 0; tile < ntile; ++tile) {
        if (tile) { mw = *(const LAS v4u*)(F.lds + mbs); __builtin_amdgcn_s_barrier(); asm volatile("" ::: "memory"); }
        ATT_LOADK1(0, 0);
        const int tn = tile + 2 < ntile ? tile + 2 : ntile - 1, sn = (stage + 2) & 3;
        ATT_SLOT(0, S0, S1, pbB, 4, pbA, 2, va, 0, 3, va, 1, 0, mw[1], 4 * tile + 1, 0);
        ATT_SLOT(1, S1, S0, pbA, 0, pbB, 0, va, 1, 1, va, 1, 2, mw[2], 4 * tile + 2, 1);
        ATT_SLOT(2, S0, S1, pbA, 4, pbB, 2, va, 1, 3, ka, 0, 0, mw[3], 4 * tile + 3, 0);
        ATT_SLOT(3, S1, S0, pbB, 0, pbA, 0, ka, 0, 1, ka, 0, 2, mwn, 4 * tile + 4, 1);
        { const int adv = (stage == 3) ? -3 * ATT_STAGE : ATT_STAGE;
#pragma unroll
          for (int i = 0; i < 4; ++i) { va[i] = ka[i]; ka[i] += adv; asm volatile("" : "+v"(ka[i])); }
          mbs += adv; stage = (stage + 1) & 3; }
    }
    ATT_SMQ(S1, pbB, 4, 0); ATT_SMQ(S1, pbB, 4, 1); ATT_SMQ(S1, pbB, 4, 2); ATT_SMQ(S1, pbB, 4, 3);
    o[2] = ATT_MFMA(avx, pbA, o[2], 1); ATT_LOADV1(va, 0, 3); o[3] = ATT_MFMA(avx, pbA, o[3], 1);
#pragma unroll
    for (int d = 0; d < 4; ++d) { ATT_LOADV1(va, 1, d); o[d] = ATT_MFMA(avx, pbB, o[d], 1); }
    lacc = ATT_MFMA(ones, pbB, lacc, 1);
    const float lsum = lacc[0];
#undef ATT_SMQ
#undef ATT_SLOT
#undef ATT_FENCE
#undef ATT_ORD
#undef ATT_PIN
#undef ATT_CW
#undef ATT_CQ
#undef ATT_LD32
#undef ATT_LOADK1
#undef ATT_LOADV1
    const float inv = 1.0f / lsum;
    { GAS unsigned char* orow = (GAS unsigned char*)(BIG + (size_t)t * LDB + C_K + h * HD) + 128 + 4 * hi; const float sc_ = inv * BR_ASC;
#pragma unroll
      for (int d = 0; d < 4; ++d)
#pragma unroll
          for (int q4 = 0; q4 < 4; ++q4) *(GAS unsigned*)(orow + d * 32 + 8 * q4) = cvt4_fp8(o[d][4 * q4 + 0] * sc_, o[d][4 * q4 + 1] * sc_, o[d][4 * q4 + 2] * sc_, o[d][4 * q4 + 3] * sc_); }
    asm volatile("s_waitcnt vmcnt(0) lgkmcnt(0)" ::: "memory");
    __builtin_amdgcn_s_barrier();
    asm volatile("" ::: "memory");
#undef ATT_DMA
#undef ATT_DMA_PIECE
#undef ATT_ROW
#undef ATT_KVO
#undef ATT_VVO
#undef ATT_MVO
}

__device__ __forceinline__ void phase_ffn_norm(const Frame& F, InPtrs in, const float* xres, int l) {
    bf16* H2 = (bf16*)(F.ws + WS_H2); const float* g = in[15] + (size_t)l * DM;
    int* tokE = (int*)(F.ws + WS_TAB + TAB_TOKE); float* tokW = (float*)(F.ws + WS_TAB + TAB_TOKW); int* cntB = (int*)(F.ws + WS_TAB + TAB_CNTB);
    LAS int* lc = (LAS int*)(F.lds + LDSCTL_OFF);
    const bool moe = (l & 1) != 0; const float* router = in[19] + (size_t)(l >> 1) * DM * NEXP;
    if (moe) { if (F.tid < 16) lc[F.tid] = 0;
#pragma unroll
        for (int i = 0; i < 4; ++i) { const int c_ = F.tid + 512 * i, r_ = c_ >> 1;
            *(LAS f32x4*)(F.lds + ((((r_ >> 8) * 4 + (r_ & 3)) * 2 + (c_ & 1)) << 10) + ((r_ >> 2) & 63) * 16) = *(const GAS f32x4*)(router + (size_t)c_ * 4); }
        __syncthreads(); }
    f32x4 g4[4]; gain_load(g, F.lane, g4);
    f32x4 yq[4][4];
    for (int rr = F.wave, qi_ = 0; rr < 128; rr += NWAVES, qi_ = (qi_ + 1) & 3) {
        const int row = F.bid * 128 + rr; f32x4 y[4];
        if (qi_ == 0) {
#pragma unroll
            for (int q = 0; q < 4; ++q) rms_load(xres + (size_t)(row + q * NWAVES) * DM, F.lane, yq[q]); }
#pragma unroll
        for (int j = 0; j < 4; ++j) y[j] = qi_ == 0 ? yq[0][j] : qi_ == 1 ? yq[1][j] : qi_ == 2 ? yq[2][j] : yq[3][j];
        rms_norm(g4, F.lane, y);
        row_store_fp8((unsigned char*)H2 + (size_t)row * DM, F.lane, y);
        if (moe) {
            float lg[NEXP];
#pragma unroll
            for (int e = 0; e < NEXP; ++e) lg[e] = 0.f;
#pragma unroll
            for (int j = 0; j < 4; ++j)
#pragma unroll
                for (int i = 0; i < 4; ++i) { const LAS unsigned char* rp_ = F.lds + ((j * 4 + i) << 11) + F.lane * 16; const f32x4 r0 = *(const LAS f32x4*)rp_, r1 = *(const LAS f32x4*)(rp_ + 1024);
                    const float v = y[j][i]; lg[0] += v * r0.x; lg[1] += v * r0.y; lg[2] += v * r0.z; lg[3] += v * r0.w; lg[4] += v * r1.x; lg[5] += v * r1.y; lg[6] += v * r1.z; lg[7] += v * r1.w; }
#pragma unroll
            for (int e = 0; e < NEXP; ++e) lg[e] = wave_sum(lg[e], F.lane);
            int e0 = 0; float v0 = lg[0];
#pragma unroll
            for (int e = 1; e < NEXP; ++e) if (lg[e] > v0) { v0 = lg[e]; e0 = e; }
            int e1 = -1; float v1 = -__builtin_inff();
#pragma unroll
            for (int e = 0; e < NEXP; ++e) if (e != e0 && lg[e] > v1) { v1 = lg[e]; e1 = e; }
            const float w1 = 1.0f / (1.0f + __expf(v0 - v1)), w0 = 1.0f - w1;
            if (F.lane == 0) { tokE[row * 2] = e0; tokE[row * 2 + 1] = e1; tokW[row * 2] = w0; tokW[row * 2 + 1] = w1;
                __hip_atomic_fetch_add(lc + e0, 1, __ATOMIC_RELAXED, __HIP_MEMORY_SCOPE_WORKGROUP); __hip_atomic_fetch_add(lc + 8 + e1, 1, __ATOMIC_RELAXED, __HIP_MEMORY_SCOPE_WORKGROUP); }
        }
    }
    if (moe) { __syncthreads(); if (F.tid < 16) cntB[F.bid * 16 + F.tid] = lc[F.tid]; }
}
__device__ __forceinline__ void phase_moe_assign(const Frame& F) {
    const int* tokE = (const int*)(F.ws + WS_TAB + TAB_TOKE); const float* tokW = (const float*)(F.ws + WS_TAB + TAB_TOKW); const int* cntB = (const int*)(F.ws + WS_TAB + TAB_CNTB);
    int* slotTok = (int*)(F.ws + WS_TAB + TAB_SLOTTOK); float* slotW = (float*)(F.ws + WS_TAB + TAB_SLOTW); int* pexp = (int*)(F.ws + WS_TAB + TAB_PEXP); int* npan = (int*)(F.ws + WS_TAB + TAB_NPAN);
    LAS int* tot = (LAS int*)(F.lds + LDSCTL_OFF);
    LAS int* basev = tot + 16; LAS int* pstart = tot + 32; LAS int* pend = tot + 48; LAS int* wcnt = tot + 64;
    if (F.tid < 32) tot[F.tid] = 0;
    __syncthreads();
    if (F.tid < GRID) { const GAS v4u* rowp = (const GAS v4u*)(cntB + F.tid * 16); const v4u c0 = rowp[0], c1 = rowp[1], c2 = rowp[2], c3 = rowp[3];
        const unsigned cv[16] = {c0.x, c0.y, c0.z, c0.w, c1.x, c1.y, c1.z, c1.w, c2.x, c2.y, c2.z, c2.w, c3.x, c3.y, c3.z, c3.w};
#pragma unroll
        for (int e = 0; e < 16; ++e) { __hip_atomic_fetch_add(tot + e, (int)cv[e], __ATOMIC_RELAXED, __HIP_MEMORY_SCOPE_WORKGROUP); if (F.tid < F.bid) __hip_atomic_fetch_add(basev + e, (int)cv[e], __ATOMIC_RELAXED, __HIP_MEMORY_SCOPE_WORKGROUP); } }
    __syncthreads();
    if (F.tid < 2) { int run = 0; for (int e = 0; e < NEXP; ++e) { pstart[F.tid * 8 + e] = run; run += (tot[F.tid * 8 + e] + 255) & ~255; pend[F.tid * 8 + e] = run; } }
    __syncthreads();
    if (F.tid < 256) {
        const int k = F.tid >> 7, r = F.tid & 127, row = F.bid * 128 + r, e = tokE[row * 2 + k]; (void)k; (void)r;
#pragma unroll
        for (int ee = 0; ee < NEXP; ++ee) { const unsigned long long m = __ballot(e == ee); if (F.lane == 0) wcnt[F.wave * 8 + ee] = __popcll(m); }
    }
    __syncthreads();
    if (F.tid < 256) {
        const int k = F.tid >> 7, r = F.tid & 127, row = F.bid * 128 + r, e = tokE[row * 2 + k];
        int rank = 0;
#pragma unroll
        for (int ee = 0; ee < NEXP; ++ee) { const unsigned long long m = __ballot(e == ee); if (e == ee) rank = __popcll(m & ((1ull << F.lane) - 1ull)); }
        const int off = (F.wave & 1) ? wcnt[(F.wave - 1) * 8 + e] : 0;
        const int slot = pstart[k * 8 + e] + basev[k * 8 + e] + off + rank;
        slotTok[k * (MOE_MAXP * 256) + slot] = row; slotW[k * (MOE_MAXP * 256) + slot] = tokW[row * 2 + k];
    }
    if (F.bid < NEXP) { const int e = F.bid;
        for (int k = 0; k < 2; ++k) { const int lo = pstart[k * 8 + e] + tot[k * 8 + e], hi = pend[k * 8 + e];
            for (int s = lo + F.tid; s < hi; s += NTHREADS) { slotTok[k * (MOE_MAXP * 256) + s] = 0; slotW[k * (MOE_MAXP * 256) + s] = 0.f; } } }
    if (F.bid == 0) {
        for (int k = 0; k < 2; ++k) { const int np = pend[k * 8 + 7] >> 8;
            for (int p = F.tid; p < np; p += NTHREADS) { int e = 0; while (e < 7 && (p << 8) >= pend[k * 8 + e]) ++e; pexp[k * 256 + p] = e; }
            if (F.tid == 0) npan[k] = np; } }
}

constexpr int MOE_NSPLIT = 7, MOE_KPART = DFF / 2 / MOE_NSPLIT;
static_assert(MOE_KPART * MOE_NSPLIT == DFF / 2 && MOE_KPART % 128 == 0 && (MOE_MAXP - 128) * 4 * MOE_NSPLIT <= GRID, "split-K tail");
__device__ __forceinline__ void moe_tail_combine(const Frame& F, const float* part, const int* slotTok, const float* slotW, float* out, int np) {
    const int ntu = (np - 128) * 4;
    for (int item = F.bid * NTHREADS + F.tid; item < ntu * 16384; item += GRID * NTHREADS) {
        const int u = item >> 14, rem = item & 16383, row = rem >> 6, col = (rem & 63) * 4;
        const int slot = (128 + (u >> 2)) * 256 + row; const float w = slotW[slot];
        if (w != 0.f) {
            f32x4 sum = (f32x4){0.f, 0.f, 0.f, 0.f};
#pragma unroll
            for (int pp = 0; pp < MOE_NSPLIT; ++pp) sum += *(const GAS f32x4*)(part + ((size_t)(u * MOE_NSPLIT + pp) * 65536 + (size_t)row * 256 + col));
            GAS f32x4* o = (GAS f32x4*)(out + (size_t)slotTok[slot] * DM + (u & 3) * 256 + col); *o = *o + sum * (w * (1.0f / (MOE_WSC * MOE_HSC)));
        }
    }
}

struct Args { const float* in[23]; float* out; unsigned char* ws; int ph_lo, ph_hi; };
constexpr int NPHASE = 36;

__global__ void __launch_bounds__(NTHREADS, 2) fwd_kernel(Args a) {
    extern __shared__ __attribute__((aligned(16))) unsigned char lds_[];
    Frame F;
    F.lds = (LAS unsigned char*)lds_;
    F.tid = threadIdx.x; F.lane = F.tid & 63; F.wave = __builtin_amdgcn_readfirstlane(F.tid >> 6); F.bid = blockIdx.x; const int wave0 = F.wave; F.gw = F.bid * NWAVES + F.wave; F.ws = a.ws; float* outp = a.out;
    volatile LAS unsigned* MISC = (volatile LAS unsigned*)(F.lds + MISC_OFF);
    for (int u = F.tid; u < (LDS_BYTES - LDSCTL_OFF) / 4; u += NTHREADS) ((LAS unsigned*)(F.lds + LDSCTL_OFF))[u] = 0u;
    __syncthreads();
    unsigned* ctl = (unsigned*)(a.ws + WS_CTL);
    typedef const __attribute__((address_space(4))) Args* KArgs;
#define KIN() ({ KArgs p_ = (KArgs)__builtin_amdgcn_kernarg_segment_ptr(); asm volatile("" : "+s"(p_)); (InPtrs)p_->in; })
    XcdBarrier bar = xcd_barrier_post(ctl + CW_BAR, MISC + 8);
    const int lo = a.ph_lo, hi = a.ph_hi; int ph = 0;
#ifndef PHMASK
#define PHMASK 0xFFFFFFFFu
#endif
#define EN(k) (((PHMASK) >> (k)) & 1u)
#define PHASE_BEGIN if (ph >= lo && ph < hi) { { int l_; asm volatile("v_mbcnt_lo_u32_b32 %0, -1, 0\n\tv_mbcnt_hi_u32_b32 %0, -1, %0" : "=v"(l_)); int w_ = wave0; unsigned z_ = 0u; asm volatile("" : "+s"(w_), "+s"(z_)); F.lane = l_; F.wave = w_; F.tid = w_ * 64 + l_; F.gw = F.bid * NWAVES + w_; \
      F.lds = (LAS unsigned char*)lds_ + z_; glds = (PG8_LAS unsigned char*)lds_ + z_; ws = a.ws + z_; F.ws = ws; outp = a.out + z_; \
      BIG = (bf16*)(ws + WS_BIG); XA = (bf16*)(ws + WS_XA); XB = (bf16*)(ws + WS_XB); H2 = (bf16*)(ws + WS_H2); HID = (bf16*)(ws + WS_HID); RSUM = (float*)(ws + WS_RSUM); }
#define PHASE_END   if (ph + 1 < hi) { int l2_; asm volatile("v_mbcnt_lo_u32_b32 %0, -1, 0\n\tv_mbcnt_hi_u32_b32 %0, -1, %0" : "=v"(l2_)); xcd_barrier(bar, wave0 * 64 + l2_); } } ++ph;
    unsigned char* ws = a.ws;
    bf16 *BIG, *XA, *XB, *H2, *HID; float* RSUM;
    PG8_LAS unsigned char* glds = (PG8_LAS unsigned char*)lds_;

    for (int l = 0; l < DEPTH; ++l) {
        const float* xres = (l == 0) ? KIN()[0] : outp;
        PHASE_BEGIN if constexpr (EN(0)) phase_prologue(F, KIN(), xres, l); PHASE_END
        for (int b = 0; b < NBATCH; ++b) {
            PHASE_BEGIN if constexpr (EN(1)) {
                { pg8::Gemm g8{(const bf16*)(ws + WS_HB8) + (size_t)b * SEQ * (DM / 2), (const bf16*)(ws + WS_WIN8), SEQ, 28 * 256, DM / 2, DM / 2, DM / 2};
                  pg8::TileMapOrder S8; S8.init(SEQ, 28 * 256, GRID, F.bid); S8.split = 12; S8.b0 = 12; S8.b1 = 27; pg8::EpiF8S E8{(unsigned char*)BIG, LDB * 2, 1.0f / G1_WSC};
                  pg8::gemm_phase<pg8::EpiF8S, pg8::TileMapOrder, true, true>(glds, g8, S8, E8, F.wave); }
                pg8::Gemm g{(const bf16*)(ws + WS_HB) + (size_t)b * SEQ * DM, (const bf16*)(ws + WS_WIN), SEQ, 15 * 256, DM, DM, DM};
                pg8::TileMapOrder S; S.init(SEQ, 15 * 256, GRID, F.bid); S.split = 12; S.b0 = 0; S.b1 = 24; pg8::EpiBf16P E{BIG, LDB};
                pg8::gemm_phase<pg8::EpiBf16P, pg8::TileMapOrder, true>(glds, g, S, E, F.wave);
                if (b == 0) {
                    pg8::Gemm g2{(const bf16*)(ws + WS_MEMN), (const bf16*)(ws + WS_WKV), NBATCH * NMEM, 2048, DM, DM, DM};
                    pg8::StaticOrder S2; S2.init(NBATCH * NMEM, 2048, GRID, (F.bid + 64) % GRID);        pg8::EpiBf16 E2{(bf16*)(ws + WS_MEMKV), 2048};
                    pg8::gemm_phase<pg8::EpiBf16, pg8::StaticOrder, true>(glds, g2, S2, E2, F.wave);
                }
            } PHASE_END
            PHASE_BEGIN if constexpr (EN(2)) phase_post(F, KIN(), l, b); PHASE_END
            PHASE_BEGIN if constexpr (EN(3)) phase_indexer(F); PHASE_END
            PHASE_BEGIN if constexpr (EN(4)) {
                float shiftA;
                { InPtrs in_ = KIN(); const float* p = in_[5] + l * HD; const float gq = wave_max(fmaxf(fabsf(p[F.lane]), fabsf(p[64 + F.lane])), F.lane); p = in_[6] + l * HD; const float gk = wave_max(fmaxf(fabsf(p[F.lane]), fabsf(p[64 + F.lane])), F.lane);
                  shiftA = 128.0f * gq * gk * 0.08838834764831845f * LOG2E - 15.0f; }
                for (int it = F.bid; it < 256; it += GRID) { const int h = it & 7, pr = it >> 3;
#pragma nounroll
                    for (int u2 = 0; u2 < 2; ++u2) attn_unit(F, BIG, ws + WS_VT, (const unsigned*)(ws + WS_MASK), h, u2 ? pr : 63 - pr, shiftA); }
                float shiftM;
                { int ln; asm volatile("v_mbcnt_lo_u32_b32 %0, -1, 0\n\tv_mbcnt_hi_u32_b32 %0, -1, %0" : "=v"(ln));
                  InPtrs in_ = KIN(); const float* p = in_[9] + l * MHD; const float gmq = wave_max(fmaxf(fmaxf(fabsf(p[ln]), fabsf(p[64 + ln])), fmaxf(fabsf(p[128 + ln]), fabsf(p[192 + ln]))), ln);
                  p = in_[10] + l * MHD; const float gmk = wave_max(fmaxf(fmaxf(fabsf(p[ln]), fabsf(p[64 + ln])), fmaxf(fabsf(p[128 + ln]), fabsf(p[192 + ln]))), ln);
                  shiftM = 256.0f * gmq * gmk * 0.0625f * LOG2E; }
                pg8::HeadSliceOrder S; S.init(SEQ, 1024, GRID, F.bid);
                pg8::Gemm g1{BIG + C_QM, (const bf16*)(ws + WS_MKN) + (size_t)b * 1024 * 256, SEQ, 1024, 256, LDB, 256};
                pg8::EpiMemP E1{XA, 1024, RSUM, shiftM};
                pg8::gemm_phase<pg8::EpiMemP, pg8::HeadSliceOrder, true>(glds, g1, S, E1, F.wave);
                pg8::Gemm g2{XA, (const bf16*)(ws + WS_MVT) + (size_t)b * 1024 * 256, SEQ, 1024, 256, 1024, 256};
                pg8::EpiMemO E2{(unsigned char*)BIG + 512 * (C_V >> 8) + 256, LDB * 2, RSUM, BR_ASC};
                pg8::gemm_phase<pg8::EpiMemO, pg8::HeadSliceOrder, true>(glds, g2, S, E2, F.wave);
            } PHASE_END
            PHASE_BEGIN if constexpr (EN(5)) {
                pg8::StaticOrder S; S.init(SEQ, DM, GRID, F.bid); const bf16* WBR = (const bf16*)(ws + WS_WBR);
                pg8::Gemm gc{BIG + C_CB, WBR, SEQ, DM, DM, LDB, DM}; pg8::EpiGate Ec{(const unsigned char*)(BIG + C_GC), LDB * 2, nullptr, XA, DM, 1.0f};
                pg8::gemm_phase<pg8::EpiGate, pg8::StaticOrder, true>(glds, gc, S, Ec, F.wave);
                const bf16* WBR8 = (const bf16*)(ws + WS_WBR8);
                pg8::Gemm ga{(const bf16*)((const unsigned char*)(BIG + C_K) + 128), WBR8, SEQ, DM, DM / 2, LDB, DM / 2, 256, 512}; pg8::EpiGate Ea{(const unsigned char*)(BIG + C_GA), LDB * 2, XA, XB, DM, 1.0f / (BR_ASC * BR_WSC)};
                pg8::gemm_phase<pg8::EpiGate, pg8::StaticOrder, true, true>(glds, ga, S, Ea, F.wave);
                pg8::Gemm gm{(const bf16*)((const unsigned char*)BIG + 512 * (C_V >> 8) + 256), WBR8 + (size_t)DM * DM / 2, SEQ, DM, DM / 2, LDB, DM / 2, 128, 512}; pg8::EpiGate Em{(const unsigned char*)(BIG + C_GM), LDB * 2, XB, XA, DM, 1.0f / (BR_ASC * BR_WSC)};
                pg8::gemm_phase<pg8::EpiGate, pg8::StaticOrder, true, true>(glds, gm, S, Em, F.wave);
            } PHASE_END
            PHASE_BEGIN if constexpr (EN(6)) {
                pg8::StaticOrder S; S.init(SEQ, DM, GRID, F.bid);
                pg8::Gemm g{XA, (const bf16*)(ws + WS_WOUT), SEQ, DM, DM, DM, DM};
                float one_ = 1.0f; asm volatile("" : "+s"(one_)); pg8::EpiResid E{xres + (size_t)b * SEQ * DM, outp + (size_t)b * SEQ * DM, DM, one_};
                pg8::gemm_phase<pg8::EpiResid, pg8::StaticOrder, true>(glds, g, S, E, F.wave);
                if (b == NBATCH - 1) phase_ffn_weights(F, KIN(), l);
            } PHASE_END
        }
        PHASE_BEGIN if constexpr (EN(7)) phase_ffn_norm(F, KIN(), outp, l); PHASE_END
        if ((l & 1) == 0) {
            PHASE_BEGIN if constexpr (EN(8)) {
                pg8::Gemm g{H2, (const bf16*)(ws + WS_WFF), TOK, 2 * DFF, DM / 2, DM / 2, DM / 2}; pg8::StaticOrder S; S.init(TOK, 2 * DFF, GRID, F.bid); float isc_ = 1.0f / MOE_WSC, hsc_ = MOE_HSC; asm volatile("" : "+s"(isc_), "+s"(hsc_)); pg8::EpiSwiGLU8 E{(unsigned char*)HID, DFF, isc_, hsc_};
                pg8::gemm_phase<pg8::EpiSwiGLU8, pg8::StaticOrder, true, true>(glds, g, S, E, F.wave);
            } PHASE_END
            PHASE_BEGIN if constexpr (EN(9)) {
                pg8::Gemm g{HID, (const bf16*)(ws + WS_WFF + WFF_DOWN), TOK, DM, DFF / 2, DFF / 2, DFF / 2}; pg8::StaticOrder S; S.init(TOK, DM, GRID, F.bid); float dsc_ = 1.0f / (MOE_WSC * MOE_HSC); asm volatile("" : "+s"(dsc_)); pg8::EpiResid E{outp, outp, DM, dsc_};
                pg8::gemm_phase<pg8::EpiResid, pg8::StaticOrder, true, true>(glds, g, S, E, F.wave);
            } PHASE_END
        } else {
            PHASE_BEGIN if constexpr (EN(10)) phase_moe_assign(F); PHASE_END
            for (int k = 0; k < 2; ++k) {
                const int* slotTok = (const int*)(ws + WS_TAB + TAB_SLOTTOK) + k * (MOE_MAXP * 256); const float* slotW = (const float*)(ws + WS_TAB + TAB_SLOTW) + k * (MOE_MAXP * 256);
                const int* pexp = (const int*)(ws + WS_TAB + TAB_PEXP) + k * 256; const int* npanp = (const int*)(ws + WS_TAB + TAB_NPAN) + k;
                PHASE_BEGIN if constexpr (EN(11)) {
                    int np = __builtin_amdgcn_readfirstlane(*npanp); np = np < 0 ? 0 : (np > MOE_MAXP ? MOE_MAXP : np);
                    if (k == 1) { int np0 = __builtin_amdgcn_readfirstlane(npanp[-1]); np0 = np0 > MOE_MAXP ? MOE_MAXP : np0;
                        if (np0 > 128) moe_tail_combine(F, (const float*)(ws + WS_END_FFN), slotTok - MOE_MAXP * 256, slotW - MOE_MAXP * 256, outp, np0); }
                    pg8::Gemm g{H2, (const bf16*)(ws + WS_WFF), np * 256, 2 * DFF, DM / 2, DM / 2, DM / 2};
                    pg8::MoeOrder<true> S; S.init(np * 256, 2 * DFF, GRID, F.bid); S.pexp = pexp; S.rowtok = slotTok; S.exp_stride = WFF_EXP / 2;
                    pg8::EpiSwiGLU8 E{(unsigned char*)HID, DFF, 1.0f / MOE_WSC, MOE_HSC};
                    pg8::gemm_phase<pg8::EpiSwiGLU8, pg8::MoeOrder<true>, true, true>(glds, g, S, E, F.wave);
                } PHASE_END
                PHASE_BEGIN if constexpr (EN(12)) {
                    int np = __builtin_amdgcn_readfirstlane(*npanp); np = np < 0 ? 0 : (np > MOE_MAXP ? MOE_MAXP : np);
                    const int npm = np < 128 ? np : 128;
                    pg8::Gemm g{HID, (const bf16*)(ws + WS_WFF + WFF_DOWN), npm * 256, DM, DFF / 2, DFF / 2, DFF / 2};
                    pg8::MoeOrder<false> S; S.init(npm * 256, DM, GRID, F.bid); S.pexp = pexp; S.rowtok = slotTok; S.exp_stride = WFF_EXP / 2;
                    pg8::EpiMoeDown E{slotTok, slotW, outp, DM, 1.0f / (MOE_WSC * MOE_HSC)};
                    pg8::gemm_phase<pg8::EpiMoeDown, pg8::MoeOrder<false>, true, true>(glds, g, S, E, F.wave);
                    if (np > 128) {
                        pg8::Gemm gt{HID, (const bf16*)(ws + WS_WFF + WFF_DOWN), np * 256, DM, MOE_KPART, DFF / 2, DFF / 2};
                        pg8::TailOrder St; St.nsub = (np - 128) * 4 * MOE_NSPLIT; St.c = F.bid; St.nsplit = MOE_NSPLIT; St.kpart = MOE_KPART; St.pexp = pexp; St.exp_stride = WFF_EXP / 2;
                        pg8::EpiPartF32 Et{(float*)(ws + WS_END_FFN) + (size_t)F.bid * 65536};
                        pg8::gemm_phase<pg8::EpiPartF32, pg8::TailOrder, true, true>(glds, gt, St, Et, F.wave);
                    }
                } PHASE_END
            }
            PHASE_BEGIN {
                const int* npanp = (const int*)(ws + WS_TAB + TAB_NPAN) + 1; int np1 = __builtin_amdgcn_readfirstlane(*npanp); np1 = np1 > MOE_MAXP ? MOE_MAXP : np1;
                if (np1 > 128) moe_tail_combine(F, (const float*)(ws + WS_END_FFN), (const int*)(ws + WS_TAB + TAB_SLOTTOK) + MOE_MAXP * 256, (const float*)(ws + WS_TAB + TAB_SLOTW) + MOE_MAXP * 256, outp, np1);
            } PHASE_END
        }
    }
#undef KIN
#undef PHASE_BEGIN
#undef PHASE_END
}

extern "C" void kernel_launch(void* const* d_in, const int* in_sizes, int n_in, void* d_out, int out_size, void* d_ws, size_t ws_size, hipStream_t stream) {
    static int ok = 0;
    if (ok == 0) {
        ok = -1;
        if (n_in != 23 || in_sizes[0] != TOK * DM || out_size != TOK * DM || ws_size < WS_NEED) { fprintf(stderr, "kernel_launch: unexpected shapes / workspace (n_in %d, ws %zu, need %zu)\n", n_in, ws_size, (size_t)WS_NEED); return; }
        int dev = 0, cus = 0, per_cu = 0;
        if (hipGetDevice(&dev) != hipSuccess || hipDeviceGetAttribute(&cus, hipDeviceAttributeMultiprocessorCount, dev) != hipSuccess) return;
        if (hipFuncSetAttribute((const void*)fwd_kernel, hipFuncAttributeMaxDynamicSharedMemorySize, LDS_BYTES) != hipSuccess) { fprintf(stderr, "kernel_launch: hipFuncSetAttribute failed\n"); return; }
        if (hipOccupancyMaxActiveBlocksPerMultiprocessor(&per_cu, (const void*)fwd_kernel, NTHREADS, LDS_BYTES) != hipSuccess || per_cu < 1) { fprintf(stderr, "kernel_launch: occupancy query says %d\n", per_cu); (void)hipGetLastError(); return; }
        if (cus < GRID) { fprintf(stderr, "kernel_launch: %d CUs < grid %d\n", cus, GRID); return; }
        ok = 1;
    }
    if (ok < 0) return;
    if (hipMemsetAsync((char*)d_ws + WS_CTL, 0, CTL_ZERO_BYTES, stream) != hipSuccess) return;
    Args a{};
    for (int i = 0; i < 23; ++i) a.in[i] = (const float*)d_in[i];
    a.out = (float*)d_out; a.ws = (unsigned char*)d_ws;
#if MK_N_LAUNCHES == 1
    a.ph_lo = 0; a.ph_hi = NPHASE;
    hipLaunchKernelGGL(fwd_kernel, dim3(GRID), dim3(NTHREADS), LDS_BYTES, stream, a);
#else
    for (int p = 0; p < NPHASE; ++p) { a.ph_lo = p; a.ph_hi = p + 1; hipLaunchKernelGGL(fwd_kernel, dim3(GRID), dim3(NTHREADS), LDS_BYTES, stream, a); }
#endif
}
```

```cpp
#include <hip/hip_runtime.h>
#include <cstdio>
#include <cstdint>

#ifndef MK_N_LAUNCHES
#define MK_N_LAUNCHES 1
#endif

#define GAS __attribute__((address_space(1)))
#define LAS __attribute__((address_space(3)))
typedef unsigned short bf16;
typedef unsigned v4u __attribute__((ext_vector_type(4)));
typedef unsigned v2u __attribute__((ext_vector_type(2)));
typedef float f32x4 __attribute__((ext_vector_type(4)));
typedef float f32x16 __attribute__((ext_vector_type(16)));
typedef short bf16x8 __attribute__((ext_vector_type(8)));
typedef GAS unsigned gu32;
#define RLX_AGENT __ATOMIC_RELAXED, __HIP_MEMORY_SCOPE_AGENT
#define LDS_WAIT() asm volatile("s_waitcnt lgkmcnt(0)" ::: "memory")
#define VM_WAIT() asm volatile("s_waitcnt vmcnt(0)" ::: "memory")

constexpr int DM = 1024, NBATCH = 2, SEQ = 16384, TOK = NBATCH * SEQ, DEPTH = 2;
constexpr int DIN = 10824;
constexpr int LDB = 11008;
constexpr int C_CB = 0, C_CC = 1024, C_CU = 2048, C_Q = 3072, C_K = 4096, C_V = 5120, C_QI = 6144, C_KI = 6656, C_WI = 6720, C_QM = 6912, C_GC = 7936, C_GA = 8960, C_GM = 9984;
constexpr int NH = 8, HD = 128, NIH = 8, IDIM = 64, TOPK = 256;
constexpr int NMEM = 256, NMH = 4, MHD = 256;
constexpr int DFF = 3584, NEXP = 8;
constexpr float EPS = 1e-6f;
constexpr float LOG2E = 1.4426950408889634f;
constexpr int GRID = 256;
constexpr int NWAVES = 8, NTHREADS = 512;
constexpr int MOE_MAXP = 136;

constexpr size_t MiB = 1u << 20;
constexpr size_t WS_CTL = 0, CTL_ZERO_BYTES = 1 * MiB;
constexpr size_t WS_ROPEA = 1 * MiB;
constexpr size_t WS_ROPEI = 9 * MiB;
constexpr size_t WS_TAB = 13 * MiB;
constexpr size_t WS_MEMN = 15 * MiB;
constexpr size_t WS_MEMKV = 16 * MiB;
constexpr size_t WS_MKN = 18 * MiB;
constexpr size_t WS_MVT = 19 * MiB;
constexpr size_t WS_WIN = 20 * MiB;
constexpr size_t WS_WKV = 42 * MiB;
constexpr size_t WS_WBR = 46 * MiB;
constexpr size_t WS_WOUT = 52 * MiB;
constexpr size_t WS_ACT = 54 * MiB;
constexpr size_t WS_BIG = WS_ACT;
constexpr size_t WS_HB = WS_BIG + 344 * MiB;
constexpr size_t WS_XB = WS_HB + 64 * MiB;
constexpr size_t WS_VT = WS_XB + 32 * MiB;
constexpr size_t WS_MASK = WS_VT + 32 * MiB;
constexpr size_t WS_RSUM = WS_MASK + 32 * MiB;
constexpr size_t WS_XA = WS_RSUM + 1 * MiB;
constexpr size_t WS_WIN8 = WS_VT + 16 * MiB;
constexpr size_t WS_WBR8 = WS_WIN8 + 11 * MiB;
constexpr size_t WS_HB8 = WS_XA + 32 * MiB;
constexpr size_t WS_END_MIX = WS_HB8 + 32 * MiB;
constexpr size_t WS_WFF = WS_ACT;
constexpr size_t WFF_EXP = 21 * MiB, WFF_DOWN = 14 * MiB;
constexpr size_t WS_H2 = WS_WFF + 168 * MiB;
constexpr size_t WS_HID = WS_H2 + 64 * MiB;
constexpr size_t WS_END_FFN = WS_HID + 238 * MiB;
constexpr size_t WS_NEED = WS_END_MIX > WS_END_FFN ? WS_END_MIX : WS_END_FFN;
static_assert(WS_WFF + 8 * WFF_EXP <= WS_H2 && WS_WFF + 8 * WFF_EXP <= WS_XA, "FFN weights may be converted while XA is live");
static_assert((size_t)SEQ * LDB * 2 <= 344 * MiB && (size_t)MOE_MAXP * 256 * DFF * 2 <= 238 * MiB, "map");
constexpr size_t TAB_TOKE = 0;
constexpr size_t TAB_TOKW = 256 * 1024;
constexpr size_t TAB_CNTB = 512 * 1024;
constexpr size_t TAB_SLOTTOK = 576 * 1024;
constexpr size_t TAB_SLOTW = 896 * 1024;
constexpr size_t TAB_PEXP = 1216 * 1024;
constexpr size_t TAB_NPAN = 1220 * 1024;
static_assert(2 * MOE_MAXP * 256 * 4 <= 320 * 1024, "tab");

constexpr int CW_TMO = 0, CW_CODE = 1, CW_BAR = 4096;

constexpr int RING_BYTES = 155648;
constexpr int LDSCTL_OFF = RING_BYTES, MISC_OFF = LDSCTL_OFF + 2048;
constexpr int LDS_BYTES = 163840;

__device__ __forceinline__ unsigned f2bf(float f) { unsigned u = __builtin_bit_cast(unsigned, f); return (u + 0x7fffu + ((u >> 16) & 1u)) >> 16; }
__device__ __forceinline__ unsigned pk2(float lo, float hi) { return f2bf(lo) | (f2bf(hi) << 16); }
__device__ __forceinline__ float bf2f(unsigned b) { return __builtin_bit_cast(float, b << 16); }
__device__ __forceinline__ float bflo(unsigned w) { return __builtin_bit_cast(float, w << 16); }
__device__ __forceinline__ float bfhi(unsigned w) { return __builtin_bit_cast(float, w & 0xffff0000u); }
__device__ __forceinline__ unsigned cvt_pk_bf16(float lo, float hi) { unsigned r; asm volatile("v_cvt_pk_bf16_f32 %0, %1, %2" : "=v"(r) : "v"(lo), "v"(hi)); return r; }
__device__ __forceinline__ float shfl_xor_l(float v, int o, int lane) { return __builtin_bit_cast(float, __builtin_amdgcn_ds_bpermute((lane ^ o) << 2, __builtin_bit_cast(int, v))); }
__device__ __forceinline__ float wave_sum(float v, int lane) {
#pragma unroll
    for (int o = 1; o < 64; o <<= 1) v += shfl_xor_l(v, o, lane);
    return v;
}
__device__ __forceinline__ float wave_max(float v, int lane) {
#pragma unroll
    for (int o = 1; o < 64; o <<= 1) v = fmaxf(v, shfl_xor_l(v, o, lane));
    return v;
}
__device__ __forceinline__ float fast_exp2(float x) { return __builtin_amdgcn_exp2f(x); }
typedef float f32x2_t __attribute__((ext_vector_type(2)));
__device__ __forceinline__ void unpk4_fp8(unsigned w, float (&o)[4]) { const f32x2_t lo = __builtin_amdgcn_cvt_pk_f32_fp8((int)w, false), hi = __builtin_amdgcn_cvt_pk_f32_fp8((int)w, true); o[0] = lo.x; o[1] = lo.y; o[2] = hi.x; o[3] = hi.y; }
__device__ __forceinline__ unsigned cvt4_fp8(float a, float b, float c, float d) { int w = 0; w = __builtin_amdgcn_cvt_pk_fp8_f32(a, b, w, false); w = __builtin_amdgcn_cvt_pk_fp8_f32(c, d, w, true); return (unsigned)w; }
__device__ __forceinline__ float fast_rcp(float x) { return __builtin_amdgcn_rcpf(x); }
__device__ __forceinline__ float sigmoidf_(float x) { return fast_rcp(1.0f + fast_exp2(-x * LOG2E)); }

namespace pg8 {
#define PG8_LAS __attribute__((address_space(3)))
typedef unsigned short bf16_t;
typedef unsigned u32x4 __attribute__((ext_vector_type(4)));
typedef int v4i_t __attribute__((ext_vector_type(4)));
typedef int v8i_t __attribute__((ext_vector_type(8)));
constexpr int BM = 256, BK = 64, HALF = 128, HTB = HALF * BK * 2, STAGE_BYTES = 8 * HTB, NXCD = 8, WGM = 8;

__host__ __device__ __forceinline__ int lds_byte(int r, int c) { const int st = (r >> 4) * 2 + (c >> 5), rr = r & 15, cc = c & 31, ob = rr * 64 + cc * 2; return st * 1024 + (ob ^ (((ob >> 9) & 1) << 5)); }
__host__ __device__ __forceinline__ void stage_rc(int b, int& R, int& C) { const int st = b / 1024, sb = b % 1024, swz = sb ^ (((sb >> 9) & 1) << 5); R = (st >> 1) * 16 + swz / 64; C = (st & 1) * 32 + (swz % 64) / 2; }
__host__ __device__ __forceinline__ int perm32(int rho) { const int n = rho >> 4, i = rho & 15; return 8 * (i >> 2) + 4 * n + (i & 3); }

struct Unit { int pm, pn; };
struct Gemm { const bf16_t* A; const bf16_t* Bt; int M, N, K, lda, ldb; int kinA = 128, kpairA = 256; };

struct StaticOrder {
    static constexpr bool GATHER = false;
    int nM, nN, nwg, G, c;
    __device__ void init(int M, int N, int G_, int c_) { nM = M / BM; nN = N / BM; nwg = nM * nN; G = G_; c = c_; }
    __device__ bool next(int i, Unit& u) const {
        const long L = (long)i * G + c; if (L >= nwg) return false;
        int wgid = (int)L; { const int q = nwg / NXCD, r = nwg % NXCD, xcd = wgid % NXCD, off = wgid / NXCD; wgid = (xcd < r ? xcd * (q + 1) : r * (q + 1) + (xcd - r) * q) + off; }
        const int nig = WGM * nN, gid = wgid / nig, fm = gid * WGM, gsz = (nM - fm) < WGM ? (nM - fm) : WGM;
        u.pm = fm + ((wgid % nig) % gsz); u.pn = (wgid % nig) / gsz; return true;
    }
    __device__ __forceinline__ const char* a_base(const Gemm& g, const Unit& u) const { return (const char*)(g.A + (size_t)u.pm * BM * g.lda); }
    __device__ __forceinline__ const char* b_base(const Gemm& g, const Unit& u) const { return (const char*)(g.Bt + (size_t)u.pn * BM * g.ldb); }
    __device__ __forceinline__ int a_row(const Unit&, int) const { return 0; }
};
struct TileMapOrder : StaticOrder {
    int split, b0, b1;
    __device__ bool next(int i, Unit& u) const { if (!StaticOrder::next(i, u)) return false; u.pn = u.pn < split ? b0 + u.pn : b1 + (u.pn - split); return true; }
};
struct HeadSliceOrder : StaticOrder {
    __device__ __forceinline__ const char* a_base(const Gemm& g, const Unit& u) const { return (const char*)(g.A + (size_t)u.pm * BM * g.lda + (size_t)u.pn * g.K); }
};
template <bool GATHER_> struct MoeOrder : StaticOrder {
    static constexpr bool GATHER = GATHER_;
    const int* pexp; const int* rowtok; size_t exp_stride;
    __device__ __forceinline__ const char* a_base(const Gemm& g, const Unit& u) const { return GATHER_ ? (const char*)g.A : (const char*)(g.A + (size_t)u.pm * BM * g.lda); }
    __device__ __forceinline__ const char* b_base(const Gemm& g, const Unit& u) const { const int e = __builtin_amdgcn_readfirstlane(pexp[u.pm]); return (const char*)(g.Bt + (size_t)e * exp_stride + (size_t)u.pn * BM * g.ldb); }
    __device__ __forceinline__ int a_row(const Unit& u, int r) const { return rowtok[u.pm * BM + r]; }
};

template <class Epi, class Sched, bool ALIGN_EPI, bool FP8 = false>
__device__ __forceinline__ void gemm_phase(PG8_LAS unsigned char* lds, const Gemm g, const Sched& S, const Epi& E, int wave_id) {
    int lane; asm volatile("v_mbcnt_lo_u32_b32 %0, -1, 0\n\tv_mbcnt_hi_u32_b32 %0, -1, %0" : "=v"(lane));
    const int wid = __builtin_amdgcn_readfirstlane(wave_id), tid = wid * 64 + lane, wr = wid >> 2, wc = wid & 3, fr = lane & 15, fq = lane >> 4;
    const int K = g.K, nt = K / BK;
    unsigned voffA[2][2], voffB[2];
#pragma unroll
    for (int i = 0; i < 2; ++i) { int R, C; stage_rc(tid * 16 + i * 8192, R, C); const int Rb = Epi::P16 ? (64 * (R >> 5) + 16 * ((R & 15) >> 2) + 4 * ((R >> 4) & 1) + (R & 3)) : Epi::PERM ? ((R & ~31) + perm32(R & 31)) : R;
        voffB[i] = (unsigned)(Rb * g.ldb + C) * 2u;
#pragma unroll
        for (int h = 0; h < 2; ++h) voffA[h][i] = (unsigned)(R * g.lda + C) * 2u; }
    const size_t kstep = (size_t)(BK * 2), kinA = (size_t)g.kinA, kpairA = (size_t)g.kpairA;
    const size_t hstepB = (size_t)(Epi::P16 ? 8 : HALF) * g.ldb * 2;
    const size_t hstepA = Sched::GATHER ? (size_t)0 : (size_t)HALF * g.lda * 2;
    const unsigned ldsw = (unsigned)wid * 1024u;
    const int aoff = lds_byte(wr * 64 + fr, fq * 8), boff = lds_byte(wc * 32 + fr, fq * 8);
#define PG8_SA(b, h) (((b) * 2 + (h)) * HTB)
#define PG8_SB(b, h) ((4 + (b) * 2 + (h)) * HTB)
#define PG8_STAGE(bufoff, gbase, voff) do { const char* gb_ = (const char*)(gbase); asm volatile("" : "+s"(gb_));       \
        _Pragma("unroll") for (int _i = 0; _i < 2; ++_i) { unsigned vo_ = (voff)[_i]; asm volatile("" : "+v"(vo_));       \
        __builtin_amdgcn_global_load_lds((const unsigned*)(gb_ + vo_), (PG8_LAS unsigned*)(lds + (bufoff) + ldsw + _i * 8192), 16, 0, 0); } } while (0)
#define PG8_LDA(dst, b, h) do { _Pragma("unroll") for (int m = 0; m < 4; ++m) { const v4i_t x0_ = *(const PG8_LAS v4i_t*)(lds + PG8_SA(b, h) + aoff + m * 2048), x1_ = *(const PG8_LAS v4i_t*)(lds + PG8_SA(b, h) + aoff + m * 2048 + 1024); \
        dst[m] = __builtin_shufflevector(x0_, x1_, 0, 1, 2, 3, 4, 5, 6, 7); } } while (0)
#define PG8_LDB(dst, b, h) do { _Pragma("unroll") for (int n = 0; n < 2; ++n) { const v4i_t x0_ = *(const PG8_LAS v4i_t*)(lds + PG8_SB(b, h) + boff + n * 2048), x1_ = *(const PG8_LAS v4i_t*)(lds + PG8_SB(b, h) + boff + n * 2048 + 1024); \
        dst[n] = __builtin_shufflevector(x0_, x1_, 0, 1, 2, 3, 4, 5, 6, 7); } } while (0)
#define PG8_LO(x_) __builtin_bit_cast(bf16x8, __builtin_shufflevector(x_, x_, 0, 1, 2, 3))
#define PG8_HI(x_) __builtin_bit_cast(bf16x8, __builtin_shufflevector(x_, x_, 4, 5, 6, 7))
#define PG8_MMA(ai, bj, At, Bt) do { __builtin_amdgcn_s_setprio(1); _Pragma("unroll") for (int m = 0; m < 4; ++m) _Pragma("unroll") for (int n = 0; n < 2; ++n) { \
        if constexpr (FP8) acc[ai][bj][m][n] = __builtin_amdgcn_mfma_scale_f32_16x16x128_f8f6f4(Bt[n], At[m], acc[ai][bj][m][n], 0, 0, 0, 0, 0, 0); \
        else { acc[ai][bj][m][n] = __builtin_amdgcn_mfma_f32_16x16x32_bf16(PG8_LO(Bt[n]), PG8_LO(At[m]), acc[ai][bj][m][n], 0, 0, 0); \
               acc[ai][bj][m][n] = __builtin_amdgcn_mfma_f32_16x16x32_bf16(PG8_HI(Bt[n]), PG8_HI(At[m]), acc[ai][bj][m][n], 0, 0, 0); } } \
        __builtin_amdgcn_s_setprio(0); } while (0)
#define PG8_WAIT_V(n) asm volatile("s_waitcnt vmcnt(" #n ")" ::: "memory")
#define PG8_WAIT_L(n) asm volatile("s_waitcnt lgkmcnt(" #n ")" ::: "memory")
#define PG8_BAR __builtin_amdgcn_s_barrier()
#define PG8_SCHED __builtin_amdgcn_sched_barrier(0)
    Unit cur, nxt; int ui = 0;
    if (!S.next(0, cur)) return;
    f32x4 acc[2][2][4][2];
#pragma unroll
    for (int a = 0; a < 2; ++a)
#pragma unroll
        for (int b = 0; b < 2; ++b)
#pragma unroll
            for (int m = 0; m < 4; ++m)
#pragma unroll
                for (int n = 0; n < 2; ++n) acc[a][b][m][n] = (f32x4){0.f, 0.f, 0.f, 0.f};
    v8i_t At[4], B0[2], B1[2];
    const char* cA = S.a_base(g, cur); const char* cB = S.b_base(g, cur);
    if constexpr (Sched::GATHER) {
#pragma unroll
        for (int h = 0; h < 2; ++h)
#pragma unroll
            for (int i = 0; i < 2; ++i) { int R, C; stage_rc(tid * 16 + i * 8192, R, C); voffA[h][i] = (unsigned)(S.a_row(cur, h * HALF + R) * g.lda + C) * 2u; }
    }
    PG8_STAGE(PG8_SB(0, 0), cB, voffB); PG8_STAGE(PG8_SB(0, 1), cB + hstepB, voffB); PG8_STAGE(PG8_SA(0, 0), cA, voffA[0]); PG8_STAGE(PG8_SA(0, 1), cA + hstepA, voffA[1]);
    PG8_STAGE(PG8_SB(1, 0), cB + kstep, voffB); PG8_STAGE(PG8_SA(1, 0), cA + kinA, voffA[0]); PG8_STAGE(PG8_SB(1, 1), cB + hstepB + kstep, voffB);
    if (wr == 1) PG8_BAR;
    PG8_WAIT_V(8); PG8_BAR;
    PG8_WAIT_V(6); PG8_BAR;
    for (;;) {
        const bool has_next = S.next(ui + 1, nxt);
        const char* nA = has_next ? S.a_base(g, nxt) : cA; const char* nB = has_next ? S.b_base(g, nxt) : cB;
#pragma nounroll
        for (int t = 0; t < nt; t += 2) {
            const bool last = (t == nt - 2);
            const char* a1 = cA + (size_t)(t >> 1) * kpairA + kinA;
            const char* a2 = last ? nA : cA + (size_t)((t >> 1) + 1) * kpairA; const char* b2 = last ? nB : cB + (size_t)(t + 2) * kstep;
            const char* a3 = a2 + kinA; const char* b3 = b2 + kstep;
            PG8_LDB(B0, 0, 0); PG8_LDB(B1, 0, 1); PG8_SCHED; PG8_LDA(At, 0, 0); PG8_STAGE(PG8_SA(1, 1), a1 + hstepA, voffA[1]);
            if constexpr (Sched::GATHER) {
                if (last && has_next) {
#pragma unroll
                    for (int h = 0; h < 2; ++h)
#pragma unroll
                        for (int i = 0; i < 2; ++i) { int R, C; stage_rc(tid * 16 + i * 8192, R, C); voffA[h][i] = (unsigned)(S.a_row(nxt, h * HALF + R) * g.lda + C) * 2u; }
                }
            }
            PG8_WAIT_V(8); PG8_WAIT_L(0); PG8_BAR; PG8_MMA(0, 0, At, B0); PG8_MMA(0, 1, At, B1); PG8_BAR; PG8_SCHED;
            PG8_LDA(At, 0, 1); PG8_STAGE(PG8_SB(0, 0), b2, voffB); PG8_STAGE(PG8_SB(0, 1), b2 + hstepB, voffB); PG8_STAGE(PG8_SA(0, 0), a2, voffA[0]);
            PG8_WAIT_V(8); PG8_WAIT_L(0); PG8_BAR; PG8_MMA(1, 0, At, B0); PG8_MMA(1, 1, At, B1); PG8_BAR; PG8_SCHED;
            PG8_LDB(B0, 1, 0); PG8_LDB(B1, 1, 1); PG8_SCHED; PG8_LDA(At, 1, 0); PG8_STAGE(PG8_SA(0, 1), a2 + hstepA, voffA[1]);
            PG8_WAIT_V(8); PG8_WAIT_L(0); PG8_BAR; PG8_MMA(0, 0, At, B0); PG8_MMA(0, 1, At, B1); PG8_BAR; PG8_SCHED;
            PG8_LDA(At, 1, 1); PG8_STAGE(PG8_SB(1, 0), b3, voffB); PG8_STAGE(PG8_SB(1, 1), b3 + hstepB, voffB); PG8_STAGE(PG8_SA(1, 0), a3, voffA[0]);
            PG8_WAIT_V(8); PG8_WAIT_L(0); PG8_BAR; PG8_MMA(1, 0, At, B0); PG8_MMA(1, 1, At, B1); PG8_BAR; PG8_SCHED;
        }
        if constexpr (ALIGN_EPI) { if (wr == 0) PG8_BAR; }
        { int l2_; asm volatile("v_mbcnt_lo_u32_b32 %0, -1, 0\n\tv_mbcnt_hi_u32_b32 %0, -1, %0" : "=v"(l2_));
          E(acc, cur, wr, wc, l2_ & 15, l2_ >> 4); }
        if (!has_next) break;
#pragma unroll
        for (int a = 0; a < 2; ++a)
#pragma unroll
            for (int b = 0; b < 2; ++b)
#pragma unroll
                for (int m = 0; m < 4; ++m)
#pragma unroll
                    for (int n = 0; n < 2; ++n) acc[a][b][m][n] = (f32x4){0.f, 0.f, 0.f, 0.f};
        cur = nxt; cA = nA; cB = nB; ++ui;
        if constexpr (ALIGN_EPI) { if (wr == 1) PG8_BAR; }
    }
    PG8_WAIT_V(0);
    if constexpr (!ALIGN_EPI) { if (wr == 0) PG8_BAR; }
    PG8_BAR;
#undef PG8_SA
#undef PG8_SB
#undef PG8_STAGE
#undef PG8_LDA
#undef PG8_LDB
#undef PG8_MMA
#undef PG8_LO
#undef PG8_HI
#undef PG8_WAIT_V
#undef PG8_WAIT_L
#undef PG8_BAR
#undef PG8_SCHED
}

typedef const f32x4 (&AccRef)[2][2][4][2];
struct EpiF8S {
    static constexpr bool PERM = true;
    static constexpr bool P16 = true;
    unsigned char* O; int ldcb; float osc;
    __device__ __forceinline__ void operator()(AccRef acc, const Unit& u, int wr, int wc, int fr, int fq) const {
        const int row0 = u.pm * BM + wr * 64 + fr, colb = u.pn * 512 + wc * 64 + 16 * fq;
#pragma unroll
        for (int ai = 0; ai < 2; ++ai)
#pragma unroll
            for (int m = 0; m < 4; ++m) { u32x4 w; f32x4 v;
                v = acc[ai][0][m][0] * osc; w.x = cvt4_fp8(v[0], v[1], v[2], v[3]); v = acc[ai][0][m][1] * osc; w.y = cvt4_fp8(v[0], v[1], v[2], v[3]);
                v = acc[ai][1][m][0] * osc; w.z = cvt4_fp8(v[0], v[1], v[2], v[3]); v = acc[ai][1][m][1] * osc; w.w = cvt4_fp8(v[0], v[1], v[2], v[3]);
                *(u32x4*)(O + (size_t)(row0 + ai * HALF + m * 16) * ldcb + colb) = w; }
    }
};
struct EpiBf16P {
    static constexpr bool PERM = true;
    static constexpr bool P16 = false;
    bf16_t* O; int ldc;
    __device__ __forceinline__ void operator()(AccRef acc, const Unit& u, int wr, int wc, int fr, int fq) const {
        const int row0 = u.pm * BM + wr * 64 + fr, col0 = u.pn * BM + wc * 32 + 8 * fq;
        if (u.pn >= 4 && u.pn < 12) {
#pragma unroll
            for (int ai = 0; ai < 2; ++ai)
#pragma unroll
                for (int m = 0; m < 4; ++m) { const f32x4 v0 = acc[ai][0][m][0] * acc[ai][1][m][0], v1 = acc[ai][0][m][1] * acc[ai][1][m][1];
                    u32x4 w; w.x = cvt_pk_bf16(v0[0], v0[1]); w.y = cvt_pk_bf16(v0[2], v0[3]); w.z = cvt_pk_bf16(v1[0], v1[1]); w.w = cvt_pk_bf16(v1[2], v1[3]);
                    *(u32x4*)(O + (size_t)(row0 + ai * HALF + m * 16) * ldc + col0) = w; }
        } else {
#pragma unroll
            for (int ai = 0; ai < 2; ++ai)
#pragma unroll
                for (int m = 0; m < 4; ++m) { bf16_t* rowp = O + (size_t)(row0 + ai * HALF + m * 16) * ldc + col0;
#pragma unroll
                    for (int bj = 0; bj < 2; ++bj) { const f32x4 v0 = acc[ai][bj][m][0], v1 = acc[ai][bj][m][1];
                        u32x4 w; w.x = cvt_pk_bf16(v0[0], v0[1]); w.y = cvt_pk_bf16(v0[2], v0[3]); w.z = cvt_pk_bf16(v1[0], v1[1]); w.w = cvt_pk_bf16(v1[2], v1[3]);
                        *(u32x4*)(rowp + bj * HALF) = w; } }
        }
    }
};
struct EpiBf16 {
    static constexpr bool PERM = true;
    static constexpr bool P16 = false;
    bf16_t* O; int ldc;
    __device__ __forceinline__ void operator()(AccRef acc, const Unit& u, int wr, int wc, int fr, int fq) const {
        const int row0 = u.pm * BM + wr * 64 + fr, col0 = u.pn * BM + wc * 32 + 8 * fq;
#pragma unroll
        for (int ai = 0; ai < 2; ++ai)
#pragma unroll
            for (int m = 0; m < 4; ++m) { bf16_t* rowp = O + (size_t)(row0 + ai * HALF + m * 16) * ldc + col0;
#pragma unroll
                for (int bj = 0; bj < 2; ++bj) { const f32x4 v0 = acc[ai][bj][m][0], v1 = acc[ai][bj][m][1];
                    u32x4 w; w.x = cvt_pk_bf16(v0[0], v0[1]); w.y = cvt_pk_bf16(v0[2], v0[3]); w.z = cvt_pk_bf16(v1[0], v1[1]); w.w = cvt_pk_bf16(v1[2], v1[3]);
                    *(u32x4*)(rowp + bj * HALF) = w; } }
    }
};
struct EpiMemP {
    static constexpr bool PERM = true;
    static constexpr bool P16 = false;
    bf16_t* O; int ldc; float* rowsum; float shift;
    __device__ __forceinline__ void operator()(AccRef acc, const Unit& u, int wr, int wc, int fr, int fq) const {
        const int row0 = u.pm * BM + wr * 64 + fr, col0 = u.pn * BM + wc * 32 + 8 * fq;
#pragma unroll
        for (int ai = 0; ai < 2; ++ai)
#pragma unroll
            for (int m = 0; m < 4; ++m) { const int row = row0 + ai * HALF + m * 16; bf16_t* rowp = O + (size_t)row * ldc + col0; float s = 0.f;
#pragma unroll
                for (int bj = 0; bj < 2; ++bj) { f32x4 v0 = acc[ai][bj][m][0], v1 = acc[ai][bj][m][1];
#pragma unroll
                    for (int j = 0; j < 4; ++j) { v0[j] = fast_exp2(v0[j] - shift); v1[j] = fast_exp2(v1[j] - shift); }
                    u32x4 w; w.x = cvt_pk_bf16(v0[0], v0[1]); w.y = cvt_pk_bf16(v0[2], v0[3]); w.z = cvt_pk_bf16(v1[0], v1[1]); w.w = cvt_pk_bf16(v1[2], v1[3]);
                    s += (bflo(w.x) + bfhi(w.x)) + (bflo(w.y) + bfhi(w.y)) + (bflo(w.z) + bfhi(w.z)) + (bflo(w.w) + bfhi(w.w));
                    *(u32x4*)(rowp + bj * HALF) = w; asm volatile("" ::: "memory"); }
                s += shfl_xor_l(s, 16, fr + 16 * fq); s += shfl_xor_l(s, 32, fr + 16 * fq);
                if (fq == 0) atomicAdd(rowsum + (size_t)row * 4 + u.pn, s);
                asm volatile("" ::: "memory"); }
    }
};
struct EpiMemO {
    static constexpr bool PERM = true;
    static constexpr bool P16 = false;
    unsigned char* O; int ldcb; const float* rowsum; float osc;
    __device__ __forceinline__ void operator()(AccRef acc, const Unit& u, int wr, int wc, int fr, int fq) const {
        const int row0 = u.pm * BM + wr * 64 + fr, colb = u.pn * 512 + wc * 32 + 8 * fq;
        float rs8[2][4];
#pragma unroll
        for (int ai = 0; ai < 2; ++ai)
#pragma unroll
            for (int m = 0; m < 4; ++m) rs8[ai][m] = __hip_atomic_load(rowsum + (size_t)(row0 + ai * HALF + m * 16) * 4 + u.pn, __ATOMIC_RELAXED, __HIP_MEMORY_SCOPE_AGENT);
#pragma unroll
        for (int ai = 0; ai < 2; ++ai)
#pragma unroll
            for (int m = 0; m < 4; ++m) { const int row = row0 + ai * HALF + m * 16; unsigned char* rowp = O + (size_t)row * ldcb + colb;
                const float inv = osc / rs8[ai][m];
#pragma unroll
                for (int bj = 0; bj < 2; ++bj) { const f32x4 v0 = acc[ai][bj][m][0] * inv, v1 = acc[ai][bj][m][1] * inv;
                    v2u w; w.x = cvt4_fp8(v0[0], v0[1], v0[2], v0[3]); w.y = cvt4_fp8(v1[0], v1[1], v1[2], v1[3]);
                    *(v2u*)(rowp + bj * HALF) = w; }
                asm volatile("" ::: "memory"); }
    }
};
struct EpiGate {
    static constexpr bool PERM = true;
    static constexpr bool P16 = false;
    const unsigned char* gate; int ldgb; const bf16_t* prev; bf16_t* O; int ldc; float osc;
    __device__ __forceinline__ void operator()(AccRef acc, const Unit& u, int wr, int wc, int fr, int fq) const {
        const int row0 = u.pm * BM + wr * 64 + fr, col0 = u.pn * BM + wc * 32 + 8 * fq;
#pragma unroll
        for (int ai = 0; ai < 2; ++ai) {
            v2u gw[4][2]; u32x4 pw[4][2];
#pragma unroll
            for (int m = 0; m < 4; ++m)
#pragma unroll
                for (int bj = 0; bj < 2; ++bj) { const size_t row = (size_t)(row0 + ai * HALF + m * 16); const int col = col0 + bj * HALF;
                    gw[m][bj] = *(const v2u*)(gate + row * ldgb + u.pn * 512 + wc * 32 + 8 * fq + bj * HALF);
                    pw[m][bj] = prev ? *(const u32x4*)(prev + row * ldc + col) : (u32x4){0u, 0u, 0u, 0u}; }
#pragma unroll
            for (int m = 0; m < 4; ++m)
#pragma unroll
                for (int bj = 0; bj < 2; ++bj) { const size_t row = (size_t)(row0 + ai * HALF + m * 16); const int col = col0 + bj * HALF;
                    const u32x4 p4 = pw[m][bj]; float ga[4], gb[4]; unpk4_fp8(gw[m][bj].x, ga); unpk4_fp8(gw[m][bj].y, gb);
                    f32x4 v0 = acc[ai][bj][m][0] * osc, v1 = acc[ai][bj][m][1] * osc;
                    v0[0] = v0[0] * sigmoidf_(ga[0]) + bflo(p4.x); v0[1] = v0[1] * sigmoidf_(ga[1]) + bfhi(p4.x); v0[2] = v0[2] * sigmoidf_(ga[2]) + bflo(p4.y); v0[3] = v0[3] * sigmoidf_(ga[3]) + bfhi(p4.y);
                    v1[0] = v1[0] * sigmoidf_(gb[0]) + bflo(p4.z); v1[1] = v1[1] * sigmoidf_(gb[1]) + bfhi(p4.z); v1[2] = v1[2] * sigmoidf_(gb[2]) + bflo(p4.w); v1[3] = v1[3] * sigmoidf_(gb[3]) + bfhi(p4.w);
                    u32x4 w; w.x = cvt_pk_bf16(v0[0], v0[1]); w.y = cvt_pk_bf16(v0[2], v0[3]); w.z = cvt_pk_bf16(v1[0], v1[1]); w.w = cvt_pk_bf16(v1[2], v1[3]);
                    *(u32x4*)(O + row * ldc + col) = w; }
            asm volatile("" ::: "memory"); }
    }
};
struct EpiResid {
    static constexpr bool PERM = false;
    static constexpr bool P16 = false;
    const float* res; float* out; int ldc; float osc;
    __device__ __forceinline__ void operator()(AccRef acc, const Unit& u, int wr, int wc, int fr, int fq) const {
        const int row0 = u.pm * BM + wr * 64 + fr, col0 = u.pn * BM + wc * 32 + 4 * fq;
#pragma unroll
        for (int ai = 0; ai < 2; ++ai)
#pragma unroll
            for (int mh = 0; mh < 1; ++mh) {
                f32x4 r[4][2][2];
#pragma unroll
                for (int mm = 0; mm < 4; ++mm) { const size_t off = (size_t)(row0 + ai * HALF + (4 * mh + mm) * 16) * ldc + col0;
#pragma unroll
                    for (int bj = 0; bj < 2; ++bj)
#pragma unroll
                        for (int n = 0; n < 2; ++n) r[mm][bj][n] = *(const f32x4*)(res + off + bj * HALF + n * 16); }
#pragma unroll
                for (int mm = 0; mm < 4; ++mm) { const int m = 4 * mh + mm; const size_t off = (size_t)(row0 + ai * HALF + m * 16) * ldc + col0;
#pragma unroll
                    for (int bj = 0; bj < 2; ++bj)
#pragma unroll
                        for (int n = 0; n < 2; ++n) *(f32x4*)(out + off + bj * HALF + n * 16) = r[mm][bj][n] + acc[ai][bj][m][n] * osc; }
                asm volatile("" ::: "memory"); }
    }
};
struct EpiSwiGLU {
    static constexpr bool PERM = true;
    static constexpr bool P16 = false;
    bf16_t* O; int ldc;
    __device__ __forceinline__ void operator()(AccRef acc, const Unit& u, int wr, int wc, int fr, int fq) const {
        const int row0 = u.pm * BM + wr * 64 + fr, col0 = u.pn * HALF + wc * 32 + 8 * fq;
#pragma unroll
        for (int ai = 0; ai < 2; ++ai)
#pragma unroll
            for (int m = 0; m < 4; ++m) { bf16_t* rowp = O + (size_t)(row0 + ai * HALF + m * 16) * ldc + col0;
                f32x4 h0, h1;
#pragma unroll
                for (int j = 0; j < 4; ++j) { const float g0 = acc[ai][0][m][0][j], g1 = acc[ai][0][m][1][j];
                    h0[j] = g0 * sigmoidf_(g0) * acc[ai][1][m][0][j]; h1[j] = g1 * sigmoidf_(g1) * acc[ai][1][m][1][j]; }
                u32x4 w; w.x = cvt_pk_bf16(h0[0], h0[1]); w.y = cvt_pk_bf16(h0[2], h0[3]); w.z = cvt_pk_bf16(h1[0], h1[1]); w.w = cvt_pk_bf16(h1[2], h1[3]);
                *(u32x4*)rowp = w; }
    }
};
struct EpiSwiGLU8 {
    static constexpr bool PERM = true;
    static constexpr bool P16 = false;
    unsigned char* O; int ldc; float isc, osc;
    __device__ __forceinline__ void operator()(AccRef acc, const Unit& u, int wr, int wc, int fr, int fq) const {
        const int row0 = u.pm * BM + wr * 64 + fr, col0 = u.pn * HALF + wc * 32 + 8 * fq; const float so = isc * osc;
#pragma unroll
        for (int ai = 0; ai < 2; ++ai)
#pragma unroll
            for (int m = 0; m < 4; ++m) { unsigned char* rowp = O + (size_t)(row0 + ai * HALF + m * 16) * ldc + col0;
                f32x4 h0, h1;
#pragma unroll
                for (int j = 0; j < 4; ++j) { const float g0 = acc[ai][0][m][0][j] * isc, g1 = acc[ai][0][m][1][j] * isc;
                    h0[j] = __builtin_amdgcn_fmed3f(g0 * sigmoidf_(g0) * (acc[ai][1][m][0][j] * so), -448.0f, 448.0f); h1[j] = __builtin_amdgcn_fmed3f(g1 * sigmoidf_(g1) * (acc[ai][1][m][1][j] * so), -448.0f, 448.0f); }
                v2u w; w.x = cvt4_fp8(h0[0], h0[1], h0[2], h0[3]); w.y = cvt4_fp8(h1[0], h1[1], h1[2], h1[3]);
                *(v2u*)rowp = w; }
    }
};
struct EpiMoeDown {
    static constexpr bool PERM = false;
    static constexpr bool P16 = false;
    const int* rowtok; const float* roww; float* out; int ldc; float wsc;
    __device__ __forceinline__ void operator()(AccRef acc, const Unit& u, int wr, int wc, int fr, int fq) const {
        const int row0 = u.pm * BM + wr * 64 + fr, col0 = u.pn * BM + wc * 32 + 4 * fq;
        float w8[2][4]; int t8[2][4];
#pragma unroll
        for (int ai = 0; ai < 2; ++ai)
#pragma unroll
            for (int m = 0; m < 4; ++m) { const int row = row0 + ai * HALF + m * 16; w8[ai][m] = roww[row] * wsc; t8[ai][m] = rowtok[row]; }
#pragma unroll
        for (int ai = 0; ai < 2; ++ai) {
            f32x4 r[4][2][2];
#pragma unroll
            for (int m = 0; m < 4; ++m) { const size_t off = (size_t)t8[ai][m] * ldc + col0;
#pragma unroll
                for (int bj = 0; bj < 2; ++bj)
#pragma unroll
                    for (int n = 0; n < 2; ++n) r[m][bj][n] = *(const f32x4*)(out + off + bj * HALF + n * 16); }
#pragma unroll
            for (int m = 0; m < 4; ++m) { const float w = w8[ai][m]; const size_t off = (size_t)t8[ai][m] * ldc + col0;
                if (w != 0.f) {
#pragma unroll
                    for (int bj = 0; bj < 2; ++bj)
#pragma unroll
                        for (int n = 0; n < 2; ++n) *(f32x4*)(out + off + bj * HALF + n * 16) = r[m][bj][n] + acc[ai][bj][m][n] * w; } }
            asm volatile("" ::: "memory"); }
    }
};
struct TailOrder {
    static constexpr bool GATHER = false;
    int nsub, c, nsplit, kpart; const int* pexp; size_t exp_stride;
    __device__ bool next(int i, Unit& u) const { if (i != 0 || c >= nsub) return false; const int tu = c / nsplit; u.pm = 128 + (tu >> 2); u.pn = tu & 3; return true; }
    __device__ __forceinline__ const char* a_base(const Gemm& g, const Unit& u) const { return (const char*)(g.A + (size_t)u.pm * BM * g.lda + (size_t)(c % nsplit) * kpart); }
    __device__ __forceinline__ const char* b_base(const Gemm& g, const Unit& u) const { const int e = __builtin_amdgcn_readfirstlane(pexp[u.pm]); return (const char*)(g.Bt + (size_t)e * exp_stride + (size_t)u.pn * BM * g.ldb + (size_t)(c % nsplit) * kpart); }
    __device__ __forceinline__ int a_row(const Unit&, int) const { return 0; }
};
struct EpiPartF32 {
    static constexpr bool PERM = false;
    static constexpr bool P16 = false;
    float* tile;
    __device__ __forceinline__ void operator()(AccRef acc, const Unit&, int wr, int wc, int fr, int fq) const {
        const int row0 = wr * 64 + fr, col0 = wc * 32 + 4 * fq;
#pragma unroll
        for (int ai = 0; ai < 2; ++ai)
#pragma unroll
            for (int m = 0; m < 4; ++m) { float* rp = tile + (size_t)(row0 + ai * HALF + m * 16) * BM + col0;
#pragma unroll
                for (int bj = 0; bj < 2; ++bj)
#pragma unroll
                    for (int n = 0; n < 2; ++n) *(f32x4*)(rp + bj * HALF + n * 16) = acc[ai][bj][m][n]; }
    }
};
}

#define XB_TMO      128
#define XB_XCNT(j)  (256  + 64 * (j))
#define XB_XSUB(j)  (1280 + 64 * (j))
#define XB_XGEN(j)  (2304 + 64 * (j))
#define XB_TOP      3328
#define XB_TOPGEN   3392
#define XCD_BAR_WORDS 3456
#define XB_SPIN_CAP (1u << 22)

__device__ __forceinline__ unsigned xb_ld(unsigned* p)              { return __hip_atomic_load(p, __ATOMIC_RELAXED, __HIP_MEMORY_SCOPE_AGENT); }
__device__ __forceinline__ unsigned xb_add(unsigned* p, unsigned v) { return __hip_atomic_fetch_add(p, v, __ATOMIC_RELAXED, __HIP_MEMORY_SCOPE_AGENT); }
__device__ __forceinline__ unsigned xb_xcc_id() { return (unsigned)__builtin_amdgcn_s_getreg((3 << 11) | 20) & 0xFu; }
#define XB_SPIN(cond, bar) do { unsigned _sp = 0; while (cond) { __builtin_amdgcn_s_sleep(1); \
    if ((++_sp & 255u) == 0u) { if (xb_ld(&(bar)[XB_TMO])) break; if (_sp > XB_SPIN_CAP) { atomicAdd(&(bar)[XB_TMO], 1u); break; } } } } while (0)

struct XcdBarrier { unsigned* bar; unsigned x; volatile LAS unsigned* st; };

__device__ __forceinline__ XcdBarrier xcd_barrier_post(unsigned* bar, volatile LAS unsigned* st) {
    XcdBarrier b; b.bar = bar; b.x = xb_xcc_id(); b.st = st;
    if (threadIdx.x == 0) (void)xb_add(&bar[XB_XCNT(b.x)], 1u);
    return b;
}
__device__ __forceinline__ void xcd_barrier_complete(unsigned* bar, unsigned x, unsigned& nloc, unsigned& nx) {
    const unsigned G = gridDim.x * gridDim.y * gridDim.z;
    unsigned sum, cnt, mine, sp = 0u;
    for (;;) {
        sum = 0u; cnt = 0u; mine = 0u;
#pragma unroll
        for (unsigned j = 0; j < 16; ++j) { const unsigned c = xb_ld(&bar[XB_XCNT(j)]); sum += c; cnt += (c > 0u) ? 1u : 0u; mine = (j == x) ? c : mine; }
        if (sum == G) break;
        __builtin_amdgcn_s_sleep(1);
        if ((++sp & 255u) == 0u) { if (xb_ld(&bar[XB_TMO])) break; if (sp > XB_SPIN_CAP) { atomicAdd(&bar[XB_TMO], 1u); break; } }
    }
    nloc = mine > 0u ? mine : 1u; nx = cnt > 0u ? cnt : 1u;
}
__device__ __forceinline__ void xcd_barrier(const XcdBarrier& b, int tid) {
    asm volatile("s_waitcnt vmcnt(0)" ::: "memory");
    __syncthreads();
    if (tid == 0) {
        unsigned* bar = b.bar;
        __builtin_amdgcn_s_waitcnt(0);
        unsigned nloc = b.st[0], nx = b.st[1];
        if (nloc == 0u) { xcd_barrier_complete(bar, b.x, nloc, nx); b.st[0] = nloc; b.st[1] = nx; }
        const unsigned old = xb_add(&bar[XB_XSUB(b.x)], 1u);
        const unsigned gen = old / nloc;
        if (old + 1u == (gen + 1u) * nloc) {
            __builtin_amdgcn_fence(__ATOMIC_RELEASE, "agent");
            asm volatile("s_waitcnt vmcnt(0)" ::: "memory");
            const unsigned og = xb_add(&bar[XB_TOP], 1u);
            const unsigned tg = og / nx;
            if (og + 1u == (tg + 1u) * nx) xb_add(&bar[XB_TOPGEN], 1u);
            else XB_SPIN(xb_ld(&bar[XB_TOPGEN]) == tg, bar);
            __builtin_amdgcn_fence(__ATOMIC_ACQUIRE, "agent");
            xb_add(&bar[XB_XGEN(b.x)], 1u);
            asm volatile("s_waitcnt vmcnt(0)" ::: "memory");
        } else {
            XB_SPIN(xb_ld(&bar[XB_XGEN(b.x)]) == gen, bar);
            __builtin_amdgcn_fence(__ATOMIC_ACQUIRE, "agent");
            asm volatile("s_waitcnt vmcnt(0)" ::: "memory");
        }
    }
    __syncthreads();
}

typedef const float* const __attribute__((address_space(4)))* InPtrs;
struct Frame {
    LAS unsigned char* lds;
    int tid, lane, wave, bid, gw;
    unsigned char* ws;
};
constexpr int NGW = GRID * NWAVES;

__device__ __forceinline__ void glds16(const void* gsrc, unsigned lds_dst) { unsigned keep;
    asm volatile("s_mov_b32 %0, m0\n\ts_mov_b32 m0, %2\n\ts_nop 0\n\tglobal_load_lds_dwordx4 %1, off\n\ts_mov_b32 m0, %0" : "=&s"(keep) : "v"(gsrc), "s"(lds_dst) : "memory"); }
__device__ __forceinline__ void glds4(const void* gsrc, unsigned lds_dst) { unsigned keep;
    asm volatile("s_mov_b32 %0, m0\n\ts_mov_b32 m0, %2\n\ts_nop 0\n\tglobal_load_lds_dword %1, off\n\ts_mov_b32 m0, %0" : "=&s"(keep) : "v"(gsrc), "s"(lds_dst) : "memory"); }

__device__ __forceinline__ void glds16s(unsigned voff, const void* sbase, unsigned lds_dst) { unsigned keep;
    asm volatile("s_mov_b32 %0, m0\n\ts_mov_b32 m0, %3\n\ts_nop 0\n\tglobal_load_lds_dwordx4 %1, %2\n\ts_mov_b32 m0, %0" : "=&s"(keep) : "v"(voff), "s"(sbase), "s"(lds_dst) : "memory"); }
__device__ __forceinline__ void glds4s(unsigned voff, const void* sbase, unsigned lds_dst) { unsigned keep;
    asm volatile("s_mov_b32 %0, m0\n\ts_mov_b32 m0, %3\n\ts_nop 0\n\tglobal_load_lds_dword %1, %2\n\ts_mov_b32 m0, %0" : "=&s"(keep) : "v"(voff), "s"(sbase), "s"(lds_dst) : "memory"); }

struct MapOff { int off; __device__ __forceinline__ int operator()(int n) const { return off + n; } };
struct MapWin { __device__ __forceinline__ int operator()(int n) const { return n < 6728 ? n : n + 184; } };
struct MapWinP { __device__ __forceinline__ int operator()(int n) const { return n < 1024 ? n : n < 2048 ? 1024 + ((n - 1024) >> 7) * 256 + ((n - 1024) & 127) : n < 3072 ? 1024 + ((n - 2048) >> 7) * 256 + 128 + ((n - 2048) & 127) : n < 6728 ? n : n + 184; } };
struct MapGU  { int up; __device__ __forceinline__ int operator()(int n) const { return (n >> 7) * 256 + up * 128 + (n & 127); } };
template <class Map> __device__ __forceinline__ void transpose_item(const float* W, int K, int N, bf16* WT, const Map map, LAS unsigned* scr, int item, int lane) {
    const int nblk = (N + 63) / 64, kb = item / nblk, nb = item % nblk, k0 = 64 * kb, n0 = 64 * nb;
    const int c4 = lane & 15, kr = lane >> 4, ncol = n0 + 4 * c4;
    const bool colok = ncol < N;
    const float* src = W + (size_t)(k0 + 2 * kr) * N + ncol;
    f32x4 v0[8], v1[8];
#pragma unroll
    for (int i = 0; i < 8; ++i) { if (colok) { v0[i] = *(const GAS f32x4*)(src + (size_t)(8 * i) * N); v1[i] = *(const GAS f32x4*)(src + (size_t)(8 * i + 1) * N); } else { v0[i] = (f32x4){0.f, 0.f, 0.f, 0.f}; v1[i] = v0[i]; } }
#pragma unroll
    for (int i = 0; i < 8; ++i) { const int pw = 4 * i + kr;
#pragma unroll
        for (int j = 0; j < 4; ++j) { const int n = 4 * c4 + j; scr[n * 32 + (pw ^ ((c4 & 7) << 2))] = cvt_pk_bf16(v0[i][j], v1[i][j]); } }
    LDS_WAIT(); asm volatile("" ::: "memory");
    const int q = lane & 7;
#pragma unroll
    for (int it = 0; it < 8; ++it) { const int n = (lane >> 3) + 8 * it;
        const v4u o = *(const LAS v4u*)(scr + n * 32 + ((q ^ ((n >> 2) & 7)) << 2));
        if (n0 + n < N) *(GAS v4u*)(WT + (size_t)map(n0 + n) * K + k0 + 8 * q) = o; }
    LDS_WAIT(); asm volatile("" ::: "memory");
}
template <class Map> __device__ __forceinline__ void transpose_item8(const float* W, int K, int N, unsigned char* WT8, const Map map, float sc, int item, int lane) {
    const int nblk = (N + 63) / 64, kb = item / nblk, nb = item % nblk, k0 = 64 * kb, n0 = 64 * nb;
    const int c4 = lane & 15, kr = lane >> 4;
    if (n0 + 4 * c4 >= N) return;
    const float* src = W + (size_t)(k0 + 16 * kr) * N + n0 + 4 * c4;
    f32x4 v[16];
#pragma unroll
    for (int i = 0; i < 16; ++i) v[i] = *(const GAS f32x4*)(src + (size_t)i * N) * sc;
#pragma unroll
    for (int j = 0; j < 4; ++j) { v4u o;
        o.x = cvt4_fp8(v[0][j], v[1][j], v[2][j], v[3][j]); o.y = cvt4_fp8(v[4][j], v[5][j], v[6][j], v[7][j]); o.z = cvt4_fp8(v[8][j], v[9][j], v[10][j], v[11][j]); o.w = cvt4_fp8(v[12][j], v[13][j], v[14][j], v[15][j]);
        *(GAS v4u*)(WT8 + (size_t)map(n0 + 4 * c4 + j) * K + k0 + 16 * kr) = o; }
}
template <class Map> __device__ __forceinline__ void transpose_matrix8(const Frame& F, const float* W, int K, int N, unsigned char* WT8, const Map map, float sc, int& rot) {
    const int nitems = (K / 64) * ((N + 63) / 64);
    for (int it = (F.gw + NGW - rot) % NGW; it < nitems; it += NGW) transpose_item8(W, K, N, WT8, map, sc, it, F.lane);
    rot = (rot + nitems) % NGW;
}
template <class Map> __device__ __forceinline__ void transpose_matrix(const Frame& F, const float* W, int K, int N, bf16* WT, const Map map, int& rot) {
    LAS unsigned* scr = (LAS unsigned*)(F.lds + F.wave * 16384);
    const int nitems = (K / 64) * ((N + 63) / 64);
    for (int it = (F.gw + NGW - rot) % NGW; it < nitems; it += NGW) transpose_item(W, K, N, WT, map, scr, it, F.lane);
    rot = (rot + nitems) % NGW;
}

__device__ __forceinline__ void rms_load(const float* xrow, int lane, f32x4 (&y)[4]) {
    const GAS f32x4* xr = (const GAS f32x4*)xrow + lane;
#pragma unroll
    for (int j = 0; j < 4; ++j) y[j] = xr[64 * j];
}
__device__ __forceinline__ void rms_norm(const f32x4 (&g4)[4], int lane, f32x4 (&y)[4]) {
    float ss = 0.f;
#pragma unroll
    for (int j = 0; j < 4; ++j) ss += (y[j].x * y[j].x + y[j].y * y[j].y) + (y[j].z * y[j].z + y[j].w * y[j].w);
    const float r = 1.0f / sqrtf(wave_sum(ss, lane) * (1.0f / 1024.0f) + EPS);
#pragma unroll
    for (int j = 0; j < 4; ++j) y[j] = y[j] * r * g4[j];
}
__device__ __forceinline__ void gain_load(const float* g, int lane, f32x4 (&g4)[4]) {
    const GAS f32x4* gr = (const GAS f32x4*)g + lane;
#pragma unroll
    for (int j = 0; j < 4; ++j) g4[j] = gr[64 * j];
}
__device__ __forceinline__ void row_store_bf16(bf16* orow, int lane, const f32x4 (&y)[4]) {
    GAS v2u* o8 = (GAS v2u*)orow + lane;
#pragma unroll
    for (int j = 0; j < 4; ++j) { v2u w; w.x = pk2(y[j].x, y[j].y); w.y = pk2(y[j].z, y[j].w); o8[64 * j] = w; }
}
__device__ __forceinline__ void row_store_fp8(unsigned char* orow, int lane, const f32x4 (&y)[4]) {
    GAS unsigned* o4 = (GAS unsigned*)orow + lane;
#pragma unroll
    for (int j = 0; j < 4; ++j) o4[64 * j] = cvt4_fp8(y[j].x, y[j].y, y[j].z, y[j].w);
}
__device__ __forceinline__ void rms_row(const float* xrow, const float* g, bf16* orow, int lane, f32x4 (&y)[4]) { f32x4 g4[4]; gain_load(g, lane, g4); rms_load(xrow, lane, y); rms_norm(g4, lane, y); row_store_bf16(orow, lane, y); }

constexpr float G1_WSC = 32.0f;
__device__ __forceinline__ void phase_prologue(const Frame& F, InPtrs in, const float* xres, int l) {
    unsigned char* ws = F.ws; int rot = 0;
    { const float* W = in[3] + (size_t)l * DM * DIN; LAS unsigned* scr = (LAS unsigned*)(F.lds + F.wave * 16384);
      const int nblk = (DIN + 63) / 64, nitems = (DM / 64) * nblk;
      for (int it = F.gw; it < nitems; it += NGW) { const int n0 = 64 * (it % nblk);
          if (n0 < 3072 || (n0 >= 6144 && n0 < 6728)) transpose_item(W, DM, DIN, (bf16*)(ws + WS_WIN), MapWinP{}, scr, it, F.lane);
          if (n0 >= 3072 && (n0 < 6144 || n0 + 64 > 6728)) transpose_item8(W, DM, DIN, ws + WS_WIN8, MapWin{}, G1_WSC, it, F.lane); }
      rot = nitems % NGW; }
    transpose_matrix(F, in[8] + (size_t)l * DM * 2048, DM, 2048, (bf16*)(ws + WS_WKV), MapOff{0}, rot);
    transpose_matrix(F, in[11] + (size_t)l * DM * DM, DM, DM, (bf16*)(ws + WS_WBR), MapOff{0}, rot);
    transpose_matrix8(F, in[12] + (size_t)l * DM * DM, DM, DM, ws + WS_WBR8, MapOff{0}, 32.0f, rot);
    transpose_matrix8(F, in[13] + (size_t)l * DM * DM, DM, DM, ws + WS_WBR8 + (size_t)DM * DM, MapOff{0}, 32.0f, rot);
    transpose_matrix(F, in[14] + (size_t)l * DM * DM, DM, DM, (bf16*)(ws + WS_WOUT), MapOff{0}, rot);
    for (int it = (F.gw + NGW - (rot + NBATCH * NMEM) % NGW) % NGW; it < 184; it += NGW) { GAS v4u* p = (GAS v4u*)((bf16*)(ws + WS_WIN) + (size_t)(6728 + it) * DM); p[F.lane] = (v4u){0u, 0u, 0u, 0u}; p[64 + F.lane] = (v4u){0u, 0u, 0u, 0u}; }
    f32x4 y[4];
    for (int it = (F.gw + NGW - rot) % NGW; it < NBATCH * NMEM; it += NGW) rms_row(in[1] + (size_t)it * DM, in[7] + (size_t)l * DM, (bf16*)(ws + WS_MEMN) + (size_t)it * DM, F.lane, y);
    { f32x4 g4[4]; gain_load(in[2] + (size_t)l * DM, F.lane, g4);
      f32x4 ya[4][4], yb[4][4]; const int i0 = F.gw;
#define PRO_LD4(Y, base) do { _Pragma("unroll") for (int q = 0; q < 4; ++q) rms_load(xres + (size_t)((base) + q * NGW) * DM, F.lane, Y[q]); } while (0)
#define PRO_PR4(Y, base) do { _Pragma("unroll") for (int q = 0; q < 4; ++q) { const size_t r_ = (size_t)((base) + q * NGW); rms_norm(g4, F.lane, Y[q]); \
          row_store_bf16((bf16*)(ws + WS_HB) + r_ * DM, F.lane, Y[q]); row_store_fp8(ws + WS_HB8 + r_ * DM, F.lane, Y[q]); } } while (0)
      static_assert(TOK / NGW == 16, "prologue row batches");
      PRO_LD4(ya, i0); PRO_LD4(yb, i0 + 4 * NGW); PRO_PR4(ya, i0); PRO_LD4(ya, i0 + 8 * NGW); PRO_PR4(yb, i0 + 4 * NGW); PRO_LD4(yb, i0 + 12 * NGW); PRO_PR4(ya, i0 + 8 * NGW); PRO_PR4(yb, i0 + 12 * NGW);
#undef PRO_LD4
#undef PRO_PR4
    }
    if (l == 0) {
        float2* ta = (float2*)(ws + WS_ROPEA); float2* ti = (float2*)(ws + WS_ROPEI);
        const double L2T = 13.287712379549449;
        const double inva = exp2(-(double)F.lane * (L2T / 64.0)) * 0.15915494309189535;
        const double invi = exp2(-(double)(F.lane & 31) * (L2T / 32.0)) * 0.15915494309189535;
        for (int t = F.gw; t < SEQ; t += NGW) {
            double ra = (double)t * inva; ra -= floor(ra); const float fa = (float)ra;
            ta[(size_t)t * 64 + F.lane] = make_float2(__builtin_amdgcn_cosf(fa), __builtin_amdgcn_sinf(fa));
            double ri = (double)t * invi; ri -= floor(ri); const float fi = (float)ri;
            if (F.lane < 32) ti[(size_t)t * 32 + F.lane] = make_float2(__builtin_amdgcn_cosf(fi), __builtin_amdgcn_sinf(fi));
        }
    }
}

constexpr float MOE_WSC = 64.0f, MOE_HSC = 8.0f;
__device__ __forceinline__ void phase_ffn_weights(const Frame& F, InPtrs in, int l) {
    unsigned char* ws = F.ws; int rot = 0;
    if (l == 0) {
        bf16* gu = (bf16*)(ws + WS_WFF); bf16* dn = (bf16*)(ws + WS_WFF + WFF_DOWN);
        transpose_matrix8(F, in[16], DM, DFF, (unsigned char*)gu, MapGU{0}, MOE_WSC, rot);
        transpose_matrix8(F, in[17], DM, DFF, (unsigned char*)gu, MapGU{1}, MOE_WSC, rot);
        transpose_matrix8(F, in[18], DFF, DM, (unsigned char*)dn, MapOff{0}, MOE_WSC, rot);
    } else {
        for (int e = 0; e < NEXP; ++e) {
            unsigned char* gu = ws + WS_WFF + (size_t)e * WFF_EXP; unsigned char* dn = ws + WS_WFF + (size_t)e * WFF_EXP + WFF_DOWN;
            transpose_matrix8(F, in[20] + (size_t)e * DM * DFF, DM, DFF, gu, MapGU{0}, MOE_WSC, rot);
            transpose_matrix8(F, in[21] + (size_t)e * DM * DFF, DM, DFF, gu, MapGU{1}, MOE_WSC, rot);
            transpose_matrix8(F, in[22] + (size_t)e * DFF * DM, DFF, DM, dn, MapOff{0}, MOE_WSC, rot);
        }
    }
}

struct PostConst { f32x4 cw[3][2][2]; f32x4 gq1, gq2, gk1, gk2, g4; };
struct PostRowC { v4u pa[3][2]; v4u cb[2]; };
struct PostRow { f32x4 ra0, ra1, ri0, ri1; unsigned qk[2][2][2]; v2u qi[2], ki[2]; unsigned qm[4]; };
__device__ __forceinline__ void post_const(PostConst& C, int lane, const float* convw, const float* gq, const float* gk, const float* gmq) {
    const int c0 = lane * 16, s4 = (lane & 15) * 4;
#pragma unroll
    for (int j = 0; j < 3; ++j)
#pragma unroll
        for (int hv = 0; hv < 2; ++hv) { C.cw[j][hv][0] = *(const GAS f32x4*)(convw + j * 1024 + c0 + hv * 8); C.cw[j][hv][1] = *(const GAS f32x4*)(convw + j * 1024 + c0 + hv * 8 + 4); }
    C.gq1 = *(const GAS f32x4*)(gq + s4); C.gq2 = *(const GAS f32x4*)(gq + 64 + s4); C.gk1 = *(const GAS f32x4*)(gk + s4); C.gk2 = *(const GAS f32x4*)(gk + 64 + s4);
    C.g4 = *(const GAS f32x4*)(gmq + 4 * lane);
}
__device__ __forceinline__ void post_load_conv(PostRowC& R, const bf16* BIG, int t, int lane) {
    const bf16* r0 = BIG + (size_t)t * LDB; const int c0 = lane * 16;
#pragma unroll
    for (int j = 0; j < 3; ++j) { const int tt = t - 2 + j;
#pragma unroll
        for (int hv = 0; hv < 2; ++hv) R.pa[j][hv] = tt >= 0 ? *(const GAS v4u*)(BIG + (size_t)tt * LDB + C_CC + ((c0 >> 7) << 8) + (c0 & 127) + hv * 8) : (v4u){0u, 0u, 0u, 0u}; }
#pragma unroll
    for (int hv = 0; hv < 2; ++hv) R.cb[hv] = *(const GAS v4u*)(r0 + C_CB + c0 + hv * 8);
}
__device__ __forceinline__ void post_load(PostRow& R, const bf16* BIG, int t, int lane, const float2* ropeA, const float2* ropeI) {
    const bf16* r0 = BIG + (size_t)t * LDB;
    { const int s4 = (lane & 15) * 4, hq = lane >> 4;
      R.ra0 = *(const GAS f32x4*)((const float*)ropeA + ((size_t)t * 64 + s4) * 2); R.ra1 = *(const GAS f32x4*)((const float*)ropeA + ((size_t)t * 64 + s4) * 2 + 4);
#pragma unroll
      for (int which = 0; which < 2; ++which)
#pragma unroll
          for (int it = 0; it < 2; ++it) {
              const int H_ = it * 4 + hq; const GAS unsigned char* f8in = (const GAS unsigned char*)r0 + 512 * (((which ? C_K : C_Q) >> 8) + (H_ >> 1)) + (H_ & 1) * 128 + s4;
              R.qk[which][it][0] = *(const GAS unsigned*)f8in; R.qk[which][it][1] = *(const GAS unsigned*)(f8in + 64); } }
    { const int s4 = (lane & 7) * 4, hi8 = lane >> 3;
      R.ri0 = *(const GAS f32x4*)((const float*)ropeI + ((size_t)t * 32 + s4) * 2); R.ri1 = *(const GAS f32x4*)((const float*)ropeI + ((size_t)t * 32 + s4) * 2 + 4);
      R.qi[0] = *(const GAS v2u*)(r0 + C_QI + hi8 * IDIM + s4); R.qi[1] = *(const GAS v2u*)(r0 + C_QI + hi8 * IDIM + s4 + 32);
      if (lane < 8) { R.ki[0] = *(const GAS v2u*)(r0 + C_KI + s4); R.ki[1] = *(const GAS v2u*)(r0 + C_KI + s4 + 32); } else { R.ki[0] = (v2u){0u, 0u}; R.ki[1] = (v2u){0u, 0u}; } }
#pragma unroll
    for (int hm = 0; hm < NMH; ++hm) R.qm[hm] = *((const GAS unsigned*)((const GAS unsigned char*)r0 + 512 * ((C_QM >> 8) + hm)) + lane);
}
__device__ __forceinline__ void post_compute_conv(const PostRowC& R, const PostConst& C, bf16* BIG, int t, int lane) {
    bf16* w0 = BIG + (size_t)t * LDB;
    const int c0 = lane * 16;
    float acc[16];
#pragma unroll
    for (int i = 0; i < 16; ++i) acc[i] = 0.f;
#pragma unroll
    for (int j = 0; j < 3; ++j)
#pragma unroll
        for (int hv = 0; hv < 2; ++hv) { const v4u a = R.pa[j][hv]; const f32x4 w0_ = C.cw[j][hv][0], w1_ = C.cw[j][hv][1];
            acc[hv * 8 + 0] += w0_.x * bflo(a.x); acc[hv * 8 + 1] += w0_.y * bfhi(a.x);
            acc[hv * 8 + 2] += w0_.z * bflo(a.y); acc[hv * 8 + 3] += w0_.w * bfhi(a.y);
            acc[hv * 8 + 4] += w1_.x * bflo(a.z); acc[hv * 8 + 5] += w1_.y * bfhi(a.z);
            acc[hv * 8 + 6] += w1_.z * bflo(a.w); acc[hv * 8 + 7] += w1_.w * bfhi(a.w); }
#pragma unroll
    for (int hv = 0; hv < 2; ++hv) {
        const v4u cb = R.cb[hv]; v4u o;
        o.x = pk2(bflo(cb.x) * acc[hv * 8 + 0], bfhi(cb.x) * acc[hv * 8 + 1]); o.y = pk2(bflo(cb.y) * acc[hv * 8 + 2], bfhi(cb.y) * acc[hv * 8 + 3]);
        o.z = pk2(bflo(cb.z) * acc[hv * 8 + 4], bfhi(cb.z) * acc[hv * 8 + 5]); o.w = pk2(bflo(cb.w) * acc[hv * 8 + 6], bfhi(cb.w) * acc[hv * 8 + 7]);
        *(GAS v4u*)(w0 + C_CB + c0 + hv * 8) = o;
    }
}
__device__ __forceinline__ void post_compute(const PostRow& R, const PostConst& C, bf16* BIG, int t, int lane, float* rsum) {
    bf16* w0 = BIG + (size_t)t * LDB;
    {
        const int s4 = (lane & 15) * 4, hq = lane >> 4;
        const float cs_[4] = {R.ra0.x, R.ra0.z, R.ra1.x, R.ra1.z}, sn_[4] = {R.ra0.y, R.ra0.w, R.ra1.y, R.ra1.w};
        const float qscale = 0.08838834764831845f * LOG2E;
#pragma unroll
        for (int which = 0; which < 2; ++which) {
            const int cbase = which ? C_K : C_Q; const float osc = which ? 1.0f : qscale;
            const f32x4 g1 = which ? C.gk1 : C.gq1, g2 = which ? C.gk2 : C.gq2;
#pragma unroll
            for (int it = 0; it < 2; ++it) {
                float x1[4], x2[4]; unpk4_fp8(R.qk[which][it][0], x1); unpk4_fp8(R.qk[which][it][1], x2);
                float ss = 0.f;
#pragma unroll
                for (int j = 0; j < 4; ++j) ss += x1[j] * x1[j] + x2[j] * x2[j];
#pragma unroll
                for (int o = 1; o < 16; o <<= 1) ss += shfl_xor_l(ss, o, lane);
                const float rr = osc / sqrtf(ss * (1.0f / 128.0f) + EPS);
                float o1[4], o2[4];
#pragma unroll
                for (int j = 0; j < 4; ++j) { const float y1 = x1[j] * rr * g1[j], y2 = x2[j] * rr * g2[j]; o1[j] = y1 * cs_[j] - y2 * sn_[j]; o2[j] = y2 * cs_[j] + y1 * sn_[j]; }
                GAS unsigned char* f8 = (GAS unsigned char*)(w0 + cbase + (it * 4 + hq) * HD) + (which ? 0 : 128) + s4;
                *(GAS unsigned*)f8 = cvt4_fp8(o1[0], o1[1], o1[2], o1[3]); *(GAS unsigned*)(f8 + 64) = cvt4_fp8(o2[0], o2[1], o2[2], o2[3]);
            }
        }
    }
    {
        const int s4 = (lane & 7) * 4, hi8 = lane >> 3;
        const float cs_[4] = {R.ri0.x, R.ri0.z, R.ri1.x, R.ri1.z}, sn_[4] = {R.ri0.y, R.ri0.w, R.ri1.y, R.ri1.w};
#pragma unroll
        for (int which = 0; which < 2; ++which) {
            if (which == 1 && lane >= 8) break;
            const int off = which ? C_KI + s4 : C_QI + hi8 * IDIM + s4;
            const v2u a = which ? R.ki[0] : R.qi[0], bq = which ? R.ki[1] : R.qi[1];
            const float x1[4] = {bflo(a.x), bfhi(a.x), bflo(a.y), bfhi(a.y)}, x2[4] = {bflo(bq.x), bfhi(bq.x), bflo(bq.y), bfhi(bq.y)};
            float o1[4], o2[4];
#pragma unroll
            for (int j = 0; j < 4; ++j) { o1[j] = x1[j] * cs_[j] - x2[j] * sn_[j]; o2[j] = x2[j] * cs_[j] + x1[j] * sn_[j]; }
            v2u w1, w2; w1.x = pk2(o1[0], o1[1]); w1.y = pk2(o1[2], o1[3]); w2.x = pk2(o2[0], o2[1]); w2.y = pk2(o2[2], o2[3]);
            *(GAS v2u*)(w0 + off) = w1; *(GAS v2u*)(w0 + off + 32) = w2;
        }
    }
    {
        const f32x4 g4 = C.g4; const float ms = 0.0625f * LOG2E;
#pragma unroll
        for (int hm = 0; hm < NMH; ++hm) { GAS v2u* pw = (GAS v2u*)(w0 + C_QM + hm * MHD) + lane; float xq_[4]; unpk4_fp8(R.qm[hm], xq_);
            const float x0 = xq_[0], x1 = xq_[1], x2 = xq_[2], x3 = xq_[3];
            const float rr = ms / sqrtf(wave_sum((x0 * x0 + x1 * x1) + (x2 * x2 + x3 * x3), lane) * (1.0f / 256.0f) + EPS);
            v2u o; o.x = pk2(x0 * rr * g4.x, x1 * rr * g4.y); o.y = pk2(x2 * rr * g4.z, x3 * rr * g4.w); *pw = o; }
    }
    if (lane < 4) rsum[(size_t)t * 4 + lane] = 0.f;
}
__device__ __forceinline__ void vt_load(const bf16* BIG, int item, int lane, v4u (&v)[8]) {
    const int h = item & 7, k0 = (item >> 3) * 64;
    const GAS unsigned char* src = (const GAS unsigned char*)BIG + 512 * ((C_V >> 8) + (h >> 1)) + (h & 1) * 128;
#pragma unroll
    for (int i = 0; i < 8; ++i) { const int row = 8 * i + (lane >> 3), ch = lane & 7; v[i] = *(const GAS v4u*)(src + (size_t)(k0 + row) * (LDB * 2) + ch * 16); }
}
__device__ __forceinline__ void vt_item(const v4u (&v)[8], unsigned char* VT8, LAS unsigned char* scr, int item, int lane) {
    const int h = item & 7, k0 = (item >> 3) * 64;
#pragma unroll
    for (int i = 0; i < 8; ++i) { const int row = 8 * i + (lane >> 3), ch = lane & 7; *(LAS v4u*)(scr + row * 128 + ((ch ^ (row & 7)) << 4)) = v[i]; }
    LDS_WAIT(); asm volatile("" ::: "memory");
#pragma unroll 2
    for (int it = 0; it < 8; ++it) { const int id = it * 64 + lane, d = id >> 2, ch = id & 3; unsigned e[16];
#pragma unroll
        for (int i = 0; i < 16; ++i) { const int key = 32 * (ch & 1) + 8 * (i >> 2) + 4 * (ch >> 1) + (i & 3);
            e[i] = *(const LAS unsigned char*)(scr + key * 128 + ((((d >> 4) ^ (key & 7))) << 4) + (d & 15)); }
        v4u o; o.x = e[0] | (e[1] << 8) | (e[2] << 16) | (e[3] << 24); o.y = e[4] | (e[5] << 8) | (e[6] << 16) | (e[7] << 24);
        o.z = e[8] | (e[9] << 8) | (e[10] << 16) | (e[11] << 24); o.w = e[12] | (e[13] << 8) | (e[14] << 16) | (e[15] << 24);
        *(GAS v4u*)(VT8 + ((size_t)h * HD + d) * SEQ + k0 + ch * 16) = o; }
    LDS_WAIT(); asm volatile("" ::: "memory");
}
__device__ __forceinline__ void mem_post(const Frame& F, const float* gmk) {
    const bf16* kv = (const bf16*)(F.ws + WS_MEMKV); bf16* mkn = (bf16*)(F.ws + WS_MKN); bf16* mvt = (bf16*)(F.ws + WS_MVT);
    const int lane = F.lane;
    for (int it = F.gw; it < NBATCH * NMEM * NMH; it += NGW) { const int hm = it & 3, bm = it >> 2, b = bm >> 8, m = bm & 255;
        const v2u w = *((const GAS v2u*)(kv + (size_t)bm * 2048 + hm * MHD) + lane); const f32x4 g4 = *(const GAS f32x4*)(gmk + 4 * lane);
        const float x0 = bflo(w.x), x1 = bfhi(w.x), x2 = bflo(w.y), x3 = bfhi(w.y);
        const float rr = 1.0f / sqrtf(wave_sum((x0 * x0 + x1 * x1) + (x2 * x2 + x3 * x3), lane) * (1.0f / 256.0f) + EPS);
        v2u o; o.x = pk2(x0 * rr * g4.x, x1 * rr * g4.y); o.y = pk2(x2 * rr * g4.z, x3 * rr * g4.w);
        *((GAS v2u*)(mkn + ((size_t)b * 1024 + hm * 256 + m) * 256) + lane) = o; }
#pragma unroll
    for (int u = 0; u < (NBATCH * NMEM * 16) / NGW; ++u) { const int pr = F.gw + u * NGW, it = pr >> 4, j = pr & 15, b = it >> 8, m = it & 255;
        const int idx = j * 64 + lane; mvt[((size_t)b * 1024 + idx) * 256 + m] = kv[(size_t)it * 2048 + 1024 + idx]; }
}
__device__ __forceinline__ void phase_post(const Frame& F, InPtrs in, int l, int b) {
    bf16* BIG = (bf16*)(F.ws + WS_BIG);
    const float* convw = in[4] + (size_t)l * 3 * 1024; const float* gq = in[5] + l * HD; const float* gk = in[6] + l * HD; const float* gmq = in[9] + l * MHD;
    static_assert((SEQ / 64) * NH == NGW, "one V-transpose item per wave");
    v4u vtv[8]; vt_load(BIG, F.gw, F.lane, vtv);
    { const float2* ropeA = (const float2*)(F.ws + WS_ROPEA); const float2* ropeI = (const float2*)(F.ws + WS_ROPEI); float* rsum = (float*)(F.ws + WS_RSUM);
      PostConst C; post_const(C, F.lane, convw, gq, gk, gmq);
      { const int tb = F.gw * (SEQ / NGW), c0 = F.lane * 16; const int pcol = C_CC + ((c0 >> 7) << 8) + (c0 & 127);
        v4u pm2[2], pm1[2], pa_[2], pb_[2], cba[2], cbb[2];
#pragma unroll
        for (int hv = 0; hv < 2; ++hv) {
            pm2[hv] = tb >= 2 ? *(const GAS v4u*)(BIG + (size_t)(tb - 2) * LDB + pcol + hv * 8) : (v4u){0u, 0u, 0u, 0u};
            pm1[hv] = tb >= 1 ? *(const GAS v4u*)(BIG + (size_t)(tb - 1) * LDB + pcol + hv * 8) : (v4u){0u, 0u, 0u, 0u};
            pa_[hv] = *(const GAS v4u*)(BIG + (size_t)tb * LDB + pcol + hv * 8); cba[hv] = *(const GAS v4u*)(BIG + (size_t)tb * LDB + C_CB + c0 + hv * 8); }
#pragma unroll
        for (int k = 0; k < SEQ / NGW; k += 2) { const int t = tb + k;
#pragma unroll
            for (int hv = 0; hv < 2; ++hv) { pb_[hv] = *(const GAS v4u*)(BIG + (size_t)(t + 1) * LDB + pcol + hv * 8); cbb[hv] = *(const GAS v4u*)(BIG + (size_t)(t + 1) * LDB + C_CB + c0 + hv * 8); }
            { PostRowC R; for (int hv = 0; hv < 2; ++hv) { R.pa[0][hv] = pm2[hv]; R.pa[1][hv] = pm1[hv]; R.pa[2][hv] = pa_[hv]; R.cb[hv] = cba[hv]; } post_compute_conv(R, C, BIG, t, F.lane); }
            if (k + 2 < SEQ / NGW) {
#pragma unroll
                for (int hv = 0; hv < 2; ++hv) { cba[hv] = *(const GAS v4u*)(BIG + (size_t)(t + 2) * LDB + C_CB + c0 + hv * 8); pm2[hv] = *(const GAS v4u*)(BIG + (size_t)(t + 2) * LDB + pcol + hv * 8); } }
            { PostRowC R; for (int hv = 0; hv < 2; ++hv) { R.pa[0][hv] = pm1[hv]; R.pa[1][hv] = pa_[hv]; R.pa[2][hv] = pb_[hv]; R.cb[hv] = cbb[hv]; } post_compute_conv(R, C, BIG, t + 1, F.lane); }
#pragma unroll
            for (int hv = 0; hv < 2; ++hv) { pm1[hv] = pb_[hv]; const v4u nx = pm2[hv]; pm2[hv] = pa_[hv]; pa_[hv] = nx; } } }
      { PostRow Ra, Rb; post_load(Ra, BIG, F.gw, F.lane, ropeA, ropeI);
        for (int t = F.gw; t < SEQ; t += 2 * NGW) { const int t2 = t + NGW, t3 = t + 2 * NGW;
            post_load(Rb, BIG, t2, F.lane, ropeA, ropeI); post_compute(Ra, C, BIG, t, F.lane, rsum);
            if (t3 < SEQ) post_load(Ra, BIG, t3, F.lane, ropeA, ropeI);
            post_compute(Rb, C, BIG, t2, F.lane, rsum); } } }
    LAS unsigned char* scr = F.lds + F.wave * 16384;
    vt_item(vtv, F.ws + WS_VT, scr, F.gw, F.lane);
    if (b == 0) mem_post(F, in[10] + l * MHD);
}

constexpr int IDX_CAP = 958, IDX_PITCH = IDX_CAP + 1, IDX_WOFF = 32 * IDX_PITCH * 4;
static_assert(IDX_WOFF + 32 * 256 * 4 <= RING_BYTES, "indexer LDS");
__device__ __forceinline__ unsigned idx_pack(float sc, int key) { const unsigned b = __builtin_bit_cast(unsigned, sc); const unsigned k = b ^ ((unsigned)((int)b >> 31) | 0x80000000u); return (k & 0xFFFFC000u) | (16383u - (unsigned)key); }
__device__ __forceinline__ unsigned idx_packi(float sc, unsigned inv) { const unsigned b = __builtin_bit_cast(unsigned, sc); const unsigned k = b ^ ((unsigned)((int)b >> 31) | 0x80000000u); return (k & 0xFFFFC000u) | inv; }
__device__ __forceinline__ float idx_tau(unsigned v) { const unsigned k = v & 0xFFFFC000u; const unsigned bits = (k & 0x80000000u) ? (k ^ 0x80000000u) : ~k; return __builtin_bit_cast(float, bits); }
__device__ __forceinline__ int wave_sum4(int v) {
    return __popcll(__ballot(v & 1)) + 2 * __popcll(__ballot(v & 2)) + 4 * __popcll(__ballot(v & 4)) + 8 * __popcll(__ballot(v & 8));
}
template <bool EXACT> __device__ __forceinline__ void prune_list(LAS unsigned* lst, LAS unsigned* cntp, LAS float* taup, LAS unsigned* trash, int lane) {
    const int n = __builtin_amdgcn_readfirstlane((int)*cntp);
    unsigned e[(IDX_CAP + 63) / 64];
#pragma unroll
    for (int j = 0; j < (IDX_CAP + 63) / 64; ++j) { const int idx = lane + 64 * j; e[j] = idx < n ? lst[idx] : 0u; }
    unsigned mn = 0xFFFFFFFFu, mx = 0u;
#pragma unroll
    for (int j = 0; j < (IDX_CAP + 63) / 64; ++j) { mx = e[j] > mx ? e[j] : mx; mn = (e[j] != 0u && e[j] < mn) ? e[j] : mn; }
#pragma unroll
    for (int o = 1; o < 64; o <<= 1) { const unsigned a = (unsigned)__builtin_amdgcn_ds_bpermute((lane ^ o) << 2, (int)mx), b = (unsigned)__builtin_amdgcn_ds_bpermute((lane ^ o) << 2, (int)mn); mx = a > mx ? a : mx; mn = b < mn ? b : mn; }
    unsigned lo = mn, hi = mx + 1u, prefix = mn; int clo = n, chi = 0; bool elem = false;
#pragma unroll 1
    for (int iter = 0; iter < 4096; ++iter) {
        unsigned cand = 0u; const unsigned span = hi - lo - 1u;
#pragma unroll
        for (int j = 0; j < (IDX_CAP + 63) / 64; ++j) cand = ((e[j] - lo - 1u) < span) ? e[j] : cand;
        const unsigned long long m = __ballot(cand != 0u);
        if (m == 0ull) { prefix = lo; break; }
        const int src = (int)__builtin_ctzll(m);
        unsigned pv = (unsigned)__builtin_amdgcn_readlane((int)cand, src);
        if (!elem) { const float f = (float)((EXACT ? TOPK : TOPK + 32) - chi) / (float)(clo - chi);
            const unsigned gap = hi - lo; unsigned off = (unsigned)((float)gap * (1.0f - f)); off = off < 1u ? 1u : (off >= gap ? gap - 1u : off); pv = lo + off; }
        int cl = 0;
#pragma unroll
        for (int j = 0; j < (IDX_CAP + 63) / 64; ++j) cl += (e[j] >= pv) ? 1 : 0;
        const int c = wave_sum4(cl);
        elem = !elem && (c == clo || c == chi);
        if (c >= TOPK) { lo = pv; clo = c; prefix = pv; if (c == TOPK || (!EXACT && c <= TOPK + 64)) break; }
        else { hi = pv; chi = c; }
    }
    int kl = 0;
#pragma unroll
    for (int j = 0; j < (IDX_CAP + 63) / 64; ++j) kl += (e[j] >= prefix) ? 1 : 0;
    const unsigned long long m0 = __ballot(kl & 1), m1 = __ballot(kl & 2), m2 = __ballot(kl & 4), m3 = __ballot(kl & 8);
    const int total = __popcll(m0) + 2 * __popcll(m1) + 4 * __popcll(m2) + 8 * __popcll(m3);
#define IDX_MBC(mm) ((int)__builtin_amdgcn_mbcnt_hi((unsigned)((mm) >> 32), __builtin_amdgcn_mbcnt_lo((unsigned)(mm), 0u)))
    int pos = IDX_MBC(m0) + 2 * IDX_MBC(m1) + 4 * IDX_MBC(m2) + 8 * IDX_MBC(m3);
#undef IDX_MBC
#pragma unroll
    for (int j = 0; j < (IDX_CAP + 63) / 64; ++j) { const bool keep = e[j] >= prefix; LAS unsigned* dst = keep ? lst + pos : trash; *dst = e[j]; pos += keep ? 1 : 0; }
    if (lane == 0) { *cntp = (unsigned)total; *taup = idx_tau(prefix); }
}
__device__ __forceinline__ void indexer_group(const Frame& F, const bf16* BIG, unsigned* MASKQ, int g) {
    LAS unsigned* list = (LAS unsigned*)F.lds; LAS unsigned* wq = (LAS unsigned*)(F.lds + IDX_WOFF);
    LAS unsigned* cnt = (LAS unsigned*)(F.lds + LDSCTL_OFF); LAS float* tau = (LAS float*)(F.lds + LDSCTL_OFF + 128);
    const int lane = F.lane, wave = F.wave, c = lane & 31, hi = lane >> 5, t = 32 * g + c;
#define IDX_LOADK(dst, kb_) do { const bf16* krow_ = BIG + (size_t)(32 * (kb_) + c) * LDB + C_KI + hi * 8; _Pragma("unroll") for (int ks = 0; ks < 4; ++ks) dst[ks] = *(const GAS bf16x8*)(krow_ + ks * 16); } while (0)
    bf16x8 ka[4], kn[4];
    if (wave <= g) IDX_LOADK(ka, wave);
    if (F.tid < 32) { cnt[F.tid] = 0u; tau[F.tid] = -__builtin_inff(); }
    { const int q = F.tid >> 4; const bf16* qrow = BIG + (size_t)(32 * g + q) * LDB + C_QI;
#pragma unroll
      for (int i = 0; i < 4; ++i) { const int ch = (F.tid & 15) * 4 + i; const v4u v = *(const GAS v4u*)(qrow + ch * 8); *(LAS v4u*)((LAS unsigned char*)wq + q * 1024 + ((ch ^ (q & 15)) << 4)) = v; } }
    const LAS unsigned char* qlds = (const LAS unsigned char*)wq + c * 1024;
    float w[NIH];
    { const v4u ww = *(const GAS v4u*)(BIG + (size_t)t * LDB + C_WI); const float wscale = 0.04419417382415922f;
      w[0] = bflo(ww.x) * wscale; w[1] = bfhi(ww.x) * wscale; w[2] = bflo(ww.y) * wscale; w[3] = bfhi(ww.y) * wscale;
      w[4] = bflo(ww.z) * wscale; w[5] = bfhi(ww.z) * wscale; w[6] = bflo(ww.w) * wscale; w[7] = bfhi(ww.w) * wscale; }
    LAS float* wl = (LAS float*)(F.lds + LDSCTL_OFF + 256);
    LAS unsigned* trash = (LAS unsigned*)(F.lds + LDSCTL_OFF + 4096) + wave * 64 + lane;
    if (hi == 0) {
#pragma unroll
        for (int h = 0; h < NIH; ++h) wl[c * 8 + h] = 0.5f * w[h]; }
    __syncthreads();
    const int nkt = (g >> 3) + 1;
    int qo0[4], qo1[4];
#pragma unroll
    for (int ks = 0; ks < 4; ++ks) { qo0[ks] = ((ks * 2 + hi) ^ (c & 15)) << 4; qo1[ks] = ((8 + ks * 2 + hi) ^ (c & 15)) << 4; }
    bf16x8 qs[4];
#pragma unroll
    for (int ks = 0; ks < 4; ++ks) { float a8[8];
#pragma unroll
        for (int j = 0; j < 8; ++j) a8[j] = 0.f;
#pragma unroll
        for (int h = 0; h < NIH; ++h) { const v4u f = *(const LAS v4u*)(qlds + (h >> 1) * 256 + ((h & 1) ? qo1[ks] : qo0[ks])); const float wh = 0.5f * w[h];
            a8[0] = fmaf(bflo(f.x), wh, a8[0]); a8[1] = fmaf(bfhi(f.x), wh, a8[1]); a8[2] = fmaf(bflo(f.y), wh, a8[2]); a8[3] = fmaf(bfhi(f.y), wh, a8[3]);
            a8[4] = fmaf(bflo(f.z), wh, a8[4]); a8[5] = fmaf(bfhi(f.z), wh, a8[5]); a8[6] = fmaf(bflo(f.w), wh, a8[6]); a8[7] = fmaf(bfhi(f.w), wh, a8[7]); }
        v4u o; o.x = cvt_pk_bf16(a8[0], a8[1]); o.y = cvt_pk_bf16(a8[2], a8[3]); o.z = cvt_pk_bf16(a8[4], a8[5]); o.w = cvt_pk_bf16(a8[6], a8[7]); qs[ks] = __builtin_bit_cast(bf16x8, o); }
#define IDX_RELU_FMA(accv, wv) do { _Pragma("unroll") for (int r = 0; r < 16; ++r) asm("v_fma_f32 %0, |%1|, %2, %0" : "+v"(sc[r]) : "v"(accv[r]), "v"(wv)); } while (0)
    asm volatile("" : "+v"(ka[0]), "+v"(ka[1]), "+v"(ka[2]), "+v"(ka[3]));
    for (int kt = 0; kt < nkt; ++kt) {
        const int kb = 8 * kt + wave;
        if (kb <= g) {
            if (kb + 8 <= g) IDX_LOADK(kn, kb + 8);
            const float tauc = tau[c];
            f32x16 sc, accA, accB;
#pragma unroll
            for (int r = 0; r < 16; ++r) sc[r] = 0.f;
#pragma unroll
            for (int ks = 0; ks < 4; ++ks) sc = __builtin_amdgcn_mfma_f32_32x32x16_bf16(ka[ks], qs[ks], sc, 0, 0, 0);
            bf16x8 bA[4], bB[4]; float wprev = 0.f;
#pragma unroll
            for (int ks = 0; ks < 4; ++ks) bA[ks] = *(const LAS bf16x8*)(qlds + qo0[ks]);
#pragma unroll 1
            for (int hp = 0; hp < 4; ++hp) {
                const LAS unsigned char* qh = qlds + hp * 256;
                const float wA = wl[c * 8 + 2 * hp], wB = wl[c * 8 + 2 * hp + 1];
#pragma unroll
                for (int r = 0; r < 16; ++r) accA[r] = 0.f;
#pragma unroll
                for (int ks = 0; ks < 4; ++ks) accA = __builtin_amdgcn_mfma_f32_32x32x16_bf16(ka[ks], bA[ks], accA, 0, 0, 0);
#pragma unroll
                for (int ks = 0; ks < 4; ++ks) bB[ks] = *(const LAS bf16x8*)(qh + qo1[ks]);
                if (hp > 0) IDX_RELU_FMA(accB, wprev);
#pragma unroll
                for (int r = 0; r < 16; ++r) accB[r] = 0.f;
#pragma unroll
                for (int ks = 0; ks < 4; ++ks) accB = __builtin_amdgcn_mfma_f32_32x32x16_bf16(ka[ks], bB[ks], accB, 0, 0, 0);
                if (hp < 3) {
#pragma unroll
                    for (int ks = 0; ks < 4; ++ks) bA[ks] = *(const LAS bf16x8*)(qh + 256 + qo0[ks]);
                }
                IDX_RELU_FMA(accA, wA);
                wprev = wB;
            }
            IDX_RELU_FMA(accB, wprev);
            const int kbase = 32 * kb + 4 * hi; const unsigned ibase = 16383u - (unsigned)kbase;
            if (kb == g) {
#pragma unroll
                for (int r = 0; r < 16; ++r) sc[r] = (kbase + (r & 3) + 8 * (r >> 2) <= t) ? sc[r] : __builtin_nanf("");
            }
            int npass = 0;
#pragma unroll
            for (int r = 0; r < 16; ++r) npass += (sc[r] >= tauc) ? 1 : 0;
            int pos = (int)__hip_atomic_fetch_add(cnt + c, (unsigned)npass, __ATOMIC_RELAXED, __HIP_MEMORY_SCOPE_WORKGROUP);
            LAS unsigned* lrow = list + c * IDX_PITCH;
#pragma unroll
            for (int r = 0; r < 16; ++r) { const bool ok = sc[r] >= tauc;
                LAS unsigned* dst = ok ? lrow + pos : trash; *dst = idx_packi(sc[r], ibase - (unsigned)((r & 3) + 8 * (r >> 2))); pos += ok ? 1 : 0; }
#pragma unroll
            for (int ks = 0; ks < 4; ++ks) ka[ks] = kn[ks];
            asm volatile("" : "+v"(ka[0]), "+v"(ka[1]), "+v"(ka[2]), "+v"(ka[3]));
        }
        __syncthreads();
#pragma unroll 1
        for (int j = 0; j < 4; ++j) { const int q = wave * 4 + j; if (__builtin_amdgcn_readfirstlane((int)cnt[q]) > IDX_CAP - 256) prune_list<false>(list + q * IDX_PITCH, cnt + q, tau + q, trash, lane); }
        __syncthreads();
    }
#pragma unroll 1
    for (int j = 0; j < 4; ++j) { const int q = wave * 4 + j; if (__builtin_amdgcn_readfirstlane((int)cnt[q]) > TOPK) prune_list<true>(list + q * IDX_PITCH, cnt + q, tau + q, trash, lane); }
    __syncthreads();
    for (int p = 0; p < 2; ++p) {
        if (p == 1 && g < 256) break;
        { unsigned z_ = 0u; asm volatile("" : "+v"(z_));
          for (int i = F.tid; i < 2048; i += NTHREADS) ((LAS v4u*)wq)[i] = (v4u){z_, z_, z_, z_}; }
        __syncthreads();
#pragma unroll 1
        for (int j = 0; j < 4; ++j) { const int q = wave * 4 + j; const int n = __builtin_amdgcn_readfirstlane((int)cnt[q]);
            for (int idx = lane; idx < n; idx += 64) { const unsigned e = list[q * IDX_PITCH + idx]; const int s = 16383 - (int)(e & 0x3FFFu), kbb = s >> 5;
                if ((kbb >> 8) == p) __hip_atomic_fetch_or(wq + q * 256 + (kbb & 255), 1u << (s & 31), __ATOMIC_RELAXED, __HIP_MEMORY_SCOPE_WORKGROUP); } }
        __syncthreads();
        { const int q = F.tid >> 4;
#pragma unroll
          for (int jj = 0; jj < 4; ++jj) { const int wd = 4 * ((F.tid & 15) + 16 * jj);
              if (256 * p + wd <= g) *(GAS v4u*)(MASKQ + (size_t)(32 * g + q) * 512 + 256 * p + wd) = *(const LAS v4u*)(wq + q * 256 + wd); } }
        __syncthreads();
    }
}
#undef IDX_LOADK
#undef IDX_RELU_FMA
__device__ __forceinline__ void phase_indexer(const Frame& F) {
    const bf16* BIG = (const bf16*)(F.ws + WS_BIG); unsigned* MASKQ = (unsigned*)(F.ws + WS_MASK);
    for (int i = F.bid; i < 256; i += GRID) { indexer_group(F, BIG, MASKQ, 511 - i); indexer_group(F, BIG, MASKQ, i); }
}

constexpr float BR_ASC = 16.0f, BR_WSC = 32.0f;
typedef int v8i __attribute__((ext_vector_type(8)));
constexpr int ATT_STAGE = 36864, ATT_NST = 4, ATT_LUT = ATT_NST * ATT_STAGE;
static_assert(ATT_LUT + 256 <= RING_BYTES && ATT_LUT % 256 == 0, "attention LDS");
__device__ __forceinline__ void glds16s_lo(unsigned voff, const void* sbase, unsigned lds_dst) { unsigned keep;
    asm volatile("s_mov_b32 %0, m0\n\ts_mov_b32 m0, %3\n\ts_mov_b32 exec_hi, 0\n\ts_nop 0\n\tglobal_load_lds_dwordx4 %1, %2\n\ts_mov_b32 exec_hi, -1\n\ts_mov_b32 m0, %0" : "=&s"(keep) : "v"(voff), "s"(sbase), "s"(lds_dst) : "memory"); }
#define ATT_MFMA(a_, b_, c_, bfmt_) __builtin_amdgcn_mfma_scale_f32_32x32x64_f8f6f4(a_, b_, c_, 0, bfmt_, 0, 0, 0, 0)
__device__ __forceinline__ void attn_unit(const Frame& F, bf16* BIG, const unsigned char* VT8, const unsigned* MASKQ, int h, int Qb, float shift) {
    int lane; asm volatile("v_mbcnt_lo_u32_b32 %0, -1, 0\n\tv_mbcnt_hi_u32_b32 %0, -1, %0" : "=v"(lane));
    const int wave = F.wave, c = lane & 31, hi = lane >> 5, g = 8 * Qb + wave, t = 256 * Qb + 32 * wave + c, tid = wave * 64 + lane;
    const unsigned lds0 = (unsigned)(uintptr_t)F.lds;
    v8i qf[2];
    f32x16 o[4];
#pragma unroll
    for (int d = 0; d < 4; ++d)
#pragma unroll
        for (int r = 0; r < 16; ++r) o[d][r] = 0.f;
    const int ntile = 2 * Qb + 2;
#define ATT_ROW() (8 * wave + (lane >> 3))
#define ATT_KVO() ((unsigned)(ATT_ROW() * (LDB * 2) + (((lane & 7) ^ ((ATT_ROW() >> 1) & 7)) << 4)))
#define ATT_VVO() ((unsigned)(ATT_ROW() * SEQ + (((lane & 7) ^ ((ATT_ROW() >> 1) & 7)) << 4)))
#define ATT_MVO() ((unsigned)((lane & 31) * 2048))
    const unsigned char* kbase0 = (const unsigned char*)(BIG + C_K + h * HD); const unsigned char* vbase0 = VT8 + (size_t)h * HD * SEQ; const unsigned* mbase0 = MASKQ + (size_t)(256 * Qb + 32 * wave) * 512;
#define ATT_DMA_PIECE(i_, tile, stage) do { const unsigned sb_ = lds0 + (unsigned)(stage) * ATT_STAGE; \
        if ((i_) == 0) glds16s(ATT_KVO(), kbase0 + (size_t)(tile) * 128 * (LDB * 2), (unsigned)__builtin_amdgcn_readfirstlane(sb_ + wave * 1024)); \
        if ((i_) == 1) glds16s(ATT_KVO(), kbase0 + ((size_t)(tile) * 128 + 64) * (LDB * 2), (unsigned)__builtin_amdgcn_readfirstlane(sb_ + (wave + 8) * 1024)); \
        if ((i_) == 2) glds16s(ATT_VVO(), vbase0 + (tile) * 128, (unsigned)__builtin_amdgcn_readfirstlane(sb_ + 16384 + wave * 1024)); \
        if ((i_) == 3) glds16s(ATT_VVO(), vbase0 + (tile) * 128 + (size_t)64 * SEQ, (unsigned)__builtin_amdgcn_readfirstlane(sb_ + 16384 + (wave + 8) * 1024)); \
        if ((i_) == 4) glds16s_lo(ATT_MVO(), mbase0 + 4 * (tile), (unsigned)__builtin_amdgcn_readfirstlane(sb_ + 32768 + wave * 512)); } while (0)
#define ATT_DMA(tile, stage) do { ATT_DMA_PIECE(0, tile, stage); ATT_DMA_PIECE(1, tile, stage); ATT_DMA_PIECE(2, tile, stage); ATT_DMA_PIECE(3, tile, stage); ATT_DMA_PIECE(4, tile, stage); } while (0)
    const int kxh = ((c >> 1) & 7) ^ (hi << 1);
    int ka[4], va[4], mbs = 32768 + wave * 512 + c * 16;
    ka[0] = c * 128 + ((0 ^ kxh) << 4); ka[1] = c * 128 + ((1 ^ kxh) << 4); ka[2] = c * 128 + ((4 ^ kxh) << 4); ka[3] = c * 128 + ((5 ^ kxh) << 4);
#pragma unroll
    for (int i = 0; i < 4; ++i) va[i] = ka[i];
    if (tid < 16) { f32x4 e; e.x = (tid & 1) ? -shift : -__builtin_inff(); e.y = (tid & 2) ? -shift : -__builtin_inff(); e.z = (tid & 4) ? -shift : -__builtin_inff(); e.w = (tid & 8) ? -shift : -__builtin_inff();
        *(LAS f32x4*)(F.lds + ATT_LUT + tid * 16) = e; }
    ATT_DMA(0, 0); ATT_DMA((ntile > 1 ? 1 : 0), 1);
    { const GAS unsigned char* qrow = (const GAS unsigned char*)(BIG + (size_t)t * LDB + C_Q + h * HD) + 128 + hi * 32;
#pragma unroll
      for (int ks = 0; ks < 2; ++ks) { const v4u a = *(const GAS v4u*)(qrow + ks * 64), b = *(const GAS v4u*)(qrow + ks * 64 + 16);
          qf[ks] = (v8i){(int)a.x, (int)a.y, (int)a.z, (int)a.w, (int)b.x, (int)b.y, (int)b.z, (int)b.w}; } }
    asm volatile("" : "+v"(qf[0]), "+v"(qf[1]));
    const unsigned lutb = lds0 + ATT_LUT;
#define ATT_CW(w_, kb_) ({ unsigned W_ = (w_) >> (4 * hi); W_ = ((kb_) > g) ? 0u : W_; (W_ << 4) & 0xF0F0F0F0u; })
#define ATT_CQ(sv, W_, q4) do { const f32x4 e_ = *(const LAS f32x4*)(uintptr_t)(lutb | (((W_) >> (8 * (q4))) & 0xFFu)); \
        sv[4 * (q4) + 0] = e_.x; sv[4 * (q4) + 1] = e_.y; sv[4 * (q4) + 2] = e_.z; sv[4 * (q4) + 3] = e_.w; } while (0)
#define ATT_LD32(dst, a0_, a1_, off_) do { const v4u x_ = *(const LAS v4u*)(F.lds + (a0_) + (off_)), y_ = *(const LAS v4u*)(F.lds + (a1_) + (off_)); \
        dst = (v8i){(int)x_.x, (int)x_.y, (int)x_.z, (int)x_.w, (int)y_.x, (int)y_.y, (int)y_.z, (int)y_.w}; } while (0)
#define ATT_LOADK1(j_, ks_) ATT_LD32(akx, ka[2 * (ks_)], ka[2 * (ks_) + 1], (j_) * 4096)
#define ATT_LOADV1(ad_, jb_, dt_) ATT_LD32(avx, ad_[2 * (jb_)], ad_[2 * (jb_) + 1], 16384 + (dt_) * 4096)
#define ATT_SMQ(sv, pb_, dw_, g4) do { \
            const float p0_ = fast_exp2(sv[4 * (g4) + 0]), p1_ = fast_exp2(sv[4 * (g4) + 1]), p2_ = fast_exp2(sv[4 * (g4) + 2]), p3_ = fast_exp2(sv[4 * (g4) + 3]); \
            int w_ = pb_[(dw_) + (g4)]; w_ = __builtin_amdgcn_cvt_pk_bf8_f32(p0_, p1_, w_, false); w_ = __builtin_amdgcn_cvt_pk_bf8_f32(p2_, p3_, w_, true); pb_[(dw_) + (g4)] = w_; } while (0)
    f32x16 S0, S1; v8i akx, avx, pbA, pbB; v4u mw; unsigned mwn;
    f32x16 lacc; v8i ones;
#pragma unroll
    for (int r = 0; r < 16; ++r) lacc[r] = 0.f;
    { int o_ = 0x38383838; asm volatile("" : "+v"(o_)); ones = (v8i){o_, o_, o_, o_, o_, o_, o_, o_}; }
#pragma unroll
    for (int r = 0; r < 16; ++r) S1[r] = -__builtin_inff();
    { int z_ = 0; asm volatile("" : "+v"(z_));
      const v8i zz = (v8i){z_, z_, z_, z_, z_, z_, z_, z_};
      avx = zz; pbA = zz; pbB = zz; }
    int stage = 0;
    asm volatile("s_waitcnt vmcnt(5)" ::: "memory");
    mw = *(const LAS v4u*)(F.lds + mbs);
    __builtin_amdgcn_s_barrier();
    asm volatile("" ::: "memory");
    { const unsigned W0_ = ATT_CW(mw[0], 0); ATT_CQ(S0, W0_, 0); ATT_CQ(S0, W0_, 1); ATT_CQ(S0, W0_, 2); ATT_CQ(S0, W0_, 3); }
#define ATT_FENCE() __builtin_amdgcn_sched_barrier(0)
#define ATT_ORD() do { __builtin_amdgcn_sched_group_barrier(0x008, 1, 0); __builtin_amdgcn_sched_group_barrier(0x002, 20, 0); __builtin_amdgcn_sched_group_barrier(0x100, 3, 0); } while (0)
#define ATT_PIN(x_) asm volatile("" : "+v"(x_))
#define ATT_SLOT(j_, SQ, SS, PBD, DWB, PBV, DT0, VAD1, VJB1, VDT1, VAD3, VJB3, VDT3, WN, KBN, LS) do { \
        ATT_DMA_PIECE(j_, tn, sn); \
        if ((j_) == 3) ATT_DMA_PIECE(4, tn, sn); \
        if ((j_) == 2) { asm volatile("s_waitcnt vmcnt(3)" ::: "memory"); mwn = *(const LAS unsigned*)(F.lds + mbs + ((stage == 3) ? -3 * ATT_STAGE : ATT_STAGE)); } \
        ATT_FENCE(); \
        const unsigned Wn_ = ATT_CW(WN, KBN); \
        o[DT0] = ATT_MFMA(avx, PBV, o[DT0], 1); ATT_PIN(o[DT0]); ATT_SMQ(SS, PBD, DWB, 0); ATT_CQ(SS, Wn_, 0); ATT_LOADV1(VAD1, VJB1, VDT1); ATT_ORD(); \
        ATT_FENCE(); \
        SQ = ATT_MFMA(akx, qf[0], SQ, 0); ATT_PIN(SQ); ATT_SMQ(SS, PBD, DWB, 1); ATT_CQ(SS, Wn_, 1); ATT_LOADK1(j_, 1); ATT_ORD(); \
        ATT_FENCE(); \
        o[(DT0) + 1] = ATT_MFMA(avx, PBV, o[(DT0) + 1], 1); ATT_PIN(o[(DT0) + 1]); if (LS) { lacc = ATT_MFMA(ones, PBV, lacc, 1); ATT_PIN(lacc); } ATT_SMQ(SS, PBD, DWB, 2); ATT_CQ(SS, Wn_, 2); ATT_LOADV1(VAD3, VJB3, VDT3); ATT_ORD(); \
        ATT_FENCE(); \
        SQ = ATT_MFMA(akx, qf[1], SQ, 0); ATT_PIN(SQ); ATT_SMQ(SS, PBD, DWB, 3); ATT_CQ(SS, Wn_, 3); if ((j_) < 3) ATT_LOADK1((j_) + 1, 0); ATT_ORD(); \
        ATT_FENCE(); } while (0)
    for (int tile = 0; tile < ntile; ++tile) {
        if (tile) { mw = *(const LAS v4u*)(F.lds + mbs); __builtin_amdgcn_s_barrier(); asm volatile("" ::: "memory"); }
        ATT_LOADK1(0, 0);
        const int tn = tile + 2 < ntile ? tile + 2 : ntile - 1, sn = (stage + 2) & 3;
        ATT_SLOT(0, S0, S1, pbB, 4, pbA, 2, va, 0, 3, va, 1, 0, mw[1], 4 * tile + 1, 0);
        ATT_SLOT(1, S1, S0, pbA, 0, pbB, 0, va, 1, 1, va, 1, 2, mw[2], 4 * tile + 2, 1);
        ATT_SLOT(2, S0, S1, pbA, 4, pbB, 2, va, 1, 3, ka, 0, 0, mw[3], 4 * tile + 3, 0);
        ATT_SLOT(3, S1, S0, pbB, 0, pbA, 0, ka, 0, 1, ka, 0, 2, mwn, 4 * tile + 4, 1);
        { const int adv = (stage == 3) ? -3 * ATT_STAGE : ATT_STAGE;
#pragma unroll
          for (int i = 0; i < 4; ++i) { va[i] = ka[i]; ka[i] += adv; asm volatile("" : "+v"(ka[i])); }
          mbs += adv; stage = (stage + 1) & 3; }
    }
    ATT_SMQ(S1, pbB, 4, 0); ATT_SMQ(S1, pbB, 4, 1); ATT_SMQ(S1, pbB, 4, 2); ATT_SMQ(S1, pbB, 4, 3);
    o[2] = ATT_MFMA(avx, pbA, o[2], 1); ATT_LOADV1(va, 0, 3); o[3] = ATT_MFMA(avx, pbA, o[3], 1);
#pragma unroll
    for (int d = 0; d < 4; ++d) { ATT_LOADV1(va, 1, d); o[d] = ATT_MFMA(avx, pbB, o[d], 1); }
    lacc = ATT_MFMA(ones, pbB, lacc, 1);
    const float lsum = lacc[0];
#undef ATT_SMQ
#undef ATT_SLOT
#undef ATT_FENCE
#undef ATT_ORD
#undef ATT_PIN
#undef ATT_CW
#undef ATT_CQ
#undef ATT_LD32
#undef ATT_LOADK1
#undef ATT_LOADV1
    const float inv = 1.0f / lsum;
    { GAS unsigned char* orow = (GAS unsigned char*)(BIG + (size_t)t * LDB + C_K + h * HD) + 128 + 4 * hi; const float sc_ = inv * BR_ASC;
#pragma unroll
      for (int d = 0; d < 4; ++d)
#pragma unroll
          for (int q4 = 0; q4 < 4; ++q4) *(GAS unsigned*)(orow + d * 32 + 8 * q4) = cvt4_fp8(o[d][4 * q4 + 0] * sc_, o[d][4 * q4 + 1] * sc_, o[d][4 * q4 + 2] * sc_, o[d][4 * q4 + 3] * sc_); }
    asm volatile("s_waitcnt vmcnt(0) lgkmcnt(0)" ::: "memory");
    __builtin_amdgcn_s_barrier();
    asm volatile("" ::: "memory");
#undef ATT_DMA
#undef ATT_DMA_PIECE
#undef ATT_ROW
#undef ATT_KVO
#undef ATT_VVO
#undef ATT_MVO
}

__device__ __forceinline__ void phase_ffn_norm(const Frame& F, InPtrs in, const float* xres, int l) {
    bf16* H2 = (bf16*)(F.ws + WS_H2); const float* g = in[15] + (size_t)l * DM;
    int* tokE = (int*)(F.ws + WS_TAB + TAB_TOKE); float* tokW = (float*)(F.ws + WS_TAB + TAB_TOKW); int* cntB = (int*)(F.ws + WS_TAB + TAB_CNTB);
    LAS int* lc = (LAS int*)(F.lds + LDSCTL_OFF);
    const bool moe = (l & 1) != 0; const float* router = in[19] + (size_t)(l >> 1) * DM * NEXP;
    if (moe) { if (F.tid < 16) lc[F.tid] = 0;
#pragma unroll
        for (int i = 0; i < 4; ++i) { const int c_ = F.tid + 512 * i, r_ = c_ >> 1;
            *(LAS f32x4*)(F.lds + ((((r_ >> 8) * 4 + (r_ & 3)) * 2 + (c_ & 1)) << 10) + ((r_ >> 2) & 63) * 16) = *(const GAS f32x4*)(router + (size_t)c_ * 4); }
        __syncthreads(); }
    f32x4 g4[4]; gain_load(g, F.lane, g4);
    f32x4 yq[4][4];
    for (int rr = F.wave, qi_ = 0; rr < 128; rr += NWAVES, qi_ = (qi_ + 1) & 3) {
        const int row = F.bid * 128 + rr; f32x4 y[4];
        if (qi_ == 0) {
#pragma unroll
            for (int q = 0; q < 4; ++q) rms_load(xres + (size_t)(row + q * NWAVES) * DM, F.lane, yq[q]); }
#pragma unroll
        for (int j = 0; j < 4; ++j) y[j] = qi_ == 0 ? yq[0][j] : qi_ == 1 ? yq[1][j] : qi_ == 2 ? yq[2][j] : yq[3][j];
        rms_norm(g4, F.lane, y);
        row_store_fp8((unsigned char*)H2 + (size_t)row * DM, F.lane, y);
        if (moe) {
            float lg[NEXP];
#pragma unroll
            for (int e = 0; e < NEXP; ++e) lg[e] = 0.f;
#pragma unroll
            for (int j = 0; j < 4; ++j)
#pragma unroll
                for (int i = 0; i < 4; ++i) { const LAS unsigned char* rp_ = F.lds + ((j * 4 + i) << 11) + F.lane * 16; const f32x4 r0 = *(const LAS f32x4*)rp_, r1 = *(const LAS f32x4*)(rp_ + 1024);
                    const float v = y[j][i]; lg[0] += v * r0.x; lg[1] += v * r0.y; lg[2] += v * r0.z; lg[3] += v * r0.w; lg[4] += v * r1.x; lg[5] += v * r1.y; lg[6] += v * r1.z; lg[7] += v * r1.w; }
#pragma unroll
            for (int e = 0; e < NEXP; ++e) lg[e] = wave_sum(lg[e], F.lane);
            int e0 = 0; float v0 = lg[0];
#pragma unroll
            for (int e = 1; e < NEXP; ++e) if (lg[e] > v0) { v0 = lg[e]; e0 = e; }
            int e1 = -1; float v1 = -__builtin_inff();
#pragma unroll
            for (int e = 0; e < NEXP; ++e) if (e != e0 && lg[e] > v1) { v1 = lg[e]; e1 = e; }
            const float w1 = 1.0f / (1.0f + __expf(v0 - v1)), w0 = 1.0f - w1;
            if (F.lane == 0) { tokE[row * 2] = e0; tokE[row * 2 + 1] = e1; tokW[row * 2] = w0; tokW[row * 2 + 1] = w1;
                __hip_atomic_fetch_add(lc + e0, 1, __ATOMIC_RELAXED, __HIP_MEMORY_SCOPE_WORKGROUP); __hip_atomic_fetch_add(lc + 8 + e1, 1, __ATOMIC_RELAXED, __HIP_MEMORY_SCOPE_WORKGROUP); }
        }
    }
    if (moe) { __syncthreads(); if (F.tid < 16) cntB[F.bid * 16 + F.tid] = lc[F.tid]; }
}
__device__ __forceinline__ void phase_moe_assign(const Frame& F) {
    const int* tokE = (const int*)(F.ws + WS_TAB + TAB_TOKE); const float* tokW = (const float*)(F.ws + WS_TAB + TAB_TOKW); const int* cntB = (const int*)(F.ws + WS_TAB + TAB_CNTB);
    int* slotTok = (int*)(F.ws + WS_TAB + TAB_SLOTTOK); float* slotW = (float*)(F.ws + WS_TAB + TAB_SLOTW); int* pexp = (int*)(F.ws + WS_TAB + TAB_PEXP); int* npan = (int*)(F.ws + WS_TAB + TAB_NPAN);
    LAS int* tot = (LAS int*)(F.lds + LDSCTL_OFF);
    LAS int* basev = tot + 16; LAS int* pstart = tot + 32; LAS int* pend = tot + 48; LAS int* wcnt = tot + 64;
    if (F.tid < 32) tot[F.tid] = 0;
    __syncthreads();
    if (F.tid < GRID) { const GAS v4u* rowp = (const GAS v4u*)(cntB + F.tid * 16); const v4u c0 = rowp[0], c1 = rowp[1], c2 = rowp[2], c3 = rowp[3];
        const unsigned cv[16] = {c0.x, c0.y, c0.z, c0.w, c1.x, c1.y, c1.z, c1.w, c2.x, c2.y, c2.z, c2.w, c3.x, c3.y, c3.z, c3.w};
#pragma unroll
        for (int e = 0; e < 16; ++e) { __hip_atomic_fetch_add(tot + e, (int)cv[e], __ATOMIC_RELAXED, __HIP_MEMORY_SCOPE_WORKGROUP); if (F.tid < F.bid) __hip_atomic_fetch_add(basev + e, (int)cv[e], __ATOMIC_RELAXED, __HIP_MEMORY_SCOPE_WORKGROUP); } }
    __syncthreads();
    if (F.tid < 2) { int run = 0; for (int e = 0; e < NEXP; ++e) { pstart[F.tid * 8 + e] = run; run += (tot[F.tid * 8 + e] + 255) & ~255; pend[F.tid * 8 + e] = run; } }
    __syncthreads();
    if (F.tid < 256) {
        const int k = F.tid >> 7, r = F.tid & 127, row = F.bid * 128 + r, e = tokE[row * 2 + k]; (void)k; (void)r;
#pragma unroll
        for (int ee = 0; ee < NEXP; ++ee) { const unsigned long long m = __ballot(e == ee); if (F.lane == 0) wcnt[F.wave * 8 + ee] = __popcll(m); }
    }
    __syncthreads();
    if (F.tid < 256) {
        const int k = F.tid >> 7, r = F.tid & 127, row = F.bid * 128 + r, e = tokE[row * 2 + k];
        int rank = 0;
#pragma unroll
        for (int ee = 0; ee < NEXP; ++ee) { const unsigned long long m = __ballot(e == ee); if (e == ee) rank = __popcll(m & ((1ull << F.lane) - 1ull)); }
        const int off = (F.wave & 1) ? wcnt[(F.wave - 1) * 8 + e] : 0;
        const int slot = pstart[k * 8 + e] + basev[k * 8 + e] + off + rank;
        slotTok[k * (MOE_MAXP * 256) + slot] = row; slotW[k * (MOE_MAXP * 256) + slot] = tokW[row * 2 + k];
    }
    if (F.bid < NEXP) { const int e = F.bid;
        for (int k = 0; k < 2; ++k) { const int lo = pstart[k * 8 + e] + tot[k * 8 + e], hi = pend[k * 8 + e];
            for (int s = lo + F.tid; s < hi; s += NTHREADS) { slotTok[k * (MOE_MAXP * 256) + s] = 0; slotW[k * (MOE_MAXP * 256) + s] = 0.f; } } }
    if (F.bid == 0) {
        for (int k = 0; k < 2; ++k) { const int np = pend[k * 8 + 7] >> 8;
            for (int p = F.tid; p < np; p += NTHREADS) { int e = 0; while (e < 7 && (p << 8) >= pend[k * 8 + e]) ++e; pexp[k * 256 + p] = e; }
            if (F.tid == 0) npan[k] = np; } }
}

constexpr int MOE_NSPLIT = 7, MOE_KPART = DFF / 2 / MOE_NSPLIT;
static_assert(MOE_KPART * MOE_NSPLIT == DFF / 2 && MOE_KPART % 128 == 0 && (MOE_MAXP - 128) * 4 * MOE_NSPLIT <= GRID, "split-K tail");
__device__ __forceinline__ void moe_tail_combine(const Frame& F, const float* part, const int* slotTok, const float* slotW, float* out, int np) {
    const int ntu = (np - 128) * 4;
    for (int item = F.bid * NTHREADS + F.tid; item < ntu * 16384; item += GRID * NTHREADS) {
        const int u = item >> 14, rem = item & 16383, row = rem >> 6, col = (rem & 63) * 4;
        const int slot = (128 + (u >> 2)) * 256 + row; const float w = slotW[slot];
        if (w != 0.f) {
            f32x4 sum = (f32x4){0.f, 0.f, 0.f, 0.f};
#pragma unroll
            for (int pp = 0; pp < MOE_NSPLIT; ++pp) sum += *(const GAS f32x4*)(part + ((size_t)(u * MOE_NSPLIT + pp) * 65536 + (size_t)row * 256 + col));
            GAS f32x4* o = (GAS f32x4*)(out + (size_t)slotTok[slot] * DM + (u & 3) * 256 + col); *o = *o + sum * (w * (1.0f / (MOE_WSC * MOE_HSC)));
        }
    }
}

struct Args { const float* in[23]; float* out; unsigned char* ws; int ph_lo, ph_hi; };
constexpr int NPHASE = 36;

__global__ void __launch_bounds__(NTHREADS, 2) fwd_kernel(Args a) {
    extern __shared__ __attribute__((aligned(16))) unsigned char lds_[];
    Frame F;
    F.lds = (LAS unsigned char*)lds_;
    F.tid = threadIdx.x; F.lane = F.tid & 63; F.wave = __builtin_amdgcn_readfirstlane(F.tid >> 6); F.bid = blockIdx.x; const int wave0 = F.wave; F.gw = F.bid * NWAVES + F.wave; F.ws = a.ws; float* outp = a.out;
    volatile LAS unsigned* MISC = (volatile LAS unsigned*)(F.lds + MISC_OFF);
    for (int u = F.tid; u < (LDS_BYTES - LDSCTL_OFF) / 4; u += NTHREADS) ((LAS unsigned*)(F.lds + LDSCTL_OFF))[u] = 0u;
    __syncthreads();
    unsigned* ctl = (unsigned*)(a.ws + WS_CTL);
    typedef const __attribute__((address_space(4))) Args* KArgs;
#define KIN() ({ KArgs p_ = (KArgs)__builtin_amdgcn_kernarg_segment_ptr(); asm volatile("" : "+s"(p_)); (InPtrs)p_->in; })
    XcdBarrier bar = xcd_barrier_post(ctl + CW_BAR, MISC + 8);
    const int lo = a.ph_lo, hi = a.ph_hi; int ph = 0;
#ifndef PHMASK
#define PHMASK 0xFFFFFFFFu
#endif
#define EN(k) (((PHMASK) >> (k)) & 1u)
#define PHASE_BEGIN if (ph >= lo && ph < hi) { { int l_; asm volatile("v_mbcnt_lo_u32_b32 %0, -1, 0\n\tv_mbcnt_hi_u32_b32 %0, -1, %0" : "=v"(l_)); int w_ = wave0; unsigned z_ = 0u; asm volatile("" : "+s"(w_), "+s"(z_)); F.lane = l_; F.wave = w_; F.tid = w_ * 64 + l_; F.gw = F.bid * NWAVES + w_; \
      F.lds = (LAS unsigned char*)lds_ + z_; glds = (PG8_LAS unsigned char*)lds_ + z_; ws = a.ws + z_; F.ws = ws; outp = a.out + z_; \
      BIG = (bf16*)(ws + WS_BIG); XA = (bf16*)(ws + WS_XA); XB = (bf16*)(ws + WS_XB); H2 = (bf16*)(ws + WS_H2); HID = (bf16*)(ws + WS_HID); RSUM = (float*)(ws + WS_RSUM); }
#define PHASE_END   if (ph + 1 < hi) { int l2_; asm volatile("v_mbcnt_lo_u32_b32 %0, -1, 0\n\tv_mbcnt_hi_u32_b32 %0, -1, %0" : "=v"(l2_)); xcd_barrier(bar, wave0 * 64 + l2_); } } ++ph;
    unsigned char* ws = a.ws;
    bf16 *BIG, *XA, *XB, *H2, *HID; float* RSUM;
    PG8_LAS unsigned char* glds = (PG8_LAS unsigned char*)lds_;

    for (int l = 0; l < DEPTH; ++l) {
        const float* xres = (l == 0) ? KIN()[0] : outp;
        PHASE_BEGIN if constexpr (EN(0)) phase_prologue(F, KIN(), xres, l); PHASE_END
        for (int b = 0; b < NBATCH; ++b) {
            PHASE_BEGIN if constexpr (EN(1)) {
                { pg8::Gemm g8{(const bf16*)(ws + WS_HB8) + (size_t)b * SEQ * (DM / 2), (const bf16*)(ws + WS_WIN8), SEQ, 28 * 256, DM / 2, DM / 2, DM / 2};
                  pg8::TileMapOrder S8; S8.init(SEQ, 28 * 256, GRID, F.bid); S8.split = 12; S8.b0 = 12; S8.b1 = 27; pg8::EpiF8S E8{(unsigned char*)BIG, LDB * 2, 1.0f / G1_WSC};
                  pg8::gemm_phase<pg8::EpiF8S, pg8::TileMapOrder, true, true>(glds, g8, S8, E8, F.wave); }
                pg8::Gemm g{(const bf16*)(ws + WS_HB) + (size_t)b * SEQ * DM, (const bf16*)(ws + WS_WIN), SEQ, 15 * 256, DM, DM, DM};
                pg8::TileMapOrder S; S.init(SEQ, 15 * 256, GRID, F.bid); S.split = 12; S.b0 = 0; S.b1 = 24; pg8::EpiBf16P E{BIG, LDB};
                pg8::gemm_phase<pg8::EpiBf16P, pg8::TileMapOrder, true>(glds, g, S, E, F.wave);
                if (b == 0) {
                    pg8::Gemm g2{(const bf16*)(ws + WS_MEMN), (const bf16*)(ws + WS_WKV), NBATCH * NMEM, 2048, DM, DM, DM};
                    pg8::StaticOrder S2; S2.init(NBATCH * NMEM, 2048, GRID, (F.bid + 64) % GRID);        pg8::EpiBf16 E2{(bf16*)(ws + WS_MEMKV), 2048};
                    pg8::gemm_phase<pg8::EpiBf16, pg8::StaticOrder, true>(glds, g2, S2, E2, F.wave);
                }
            } PHASE_END
            PHASE_BEGIN if constexpr (EN(2)) phase_post(F, KIN(), l, b); PHASE_END
            PHASE_BEGIN if constexpr (EN(3)) phase_indexer(F); PHASE_END
            PHASE_BEGIN if constexpr (EN(4)) {
                float shiftA;
                { InPtrs in_ = KIN(); const float* p = in_[5] + l * HD; const float gq = wave_max(fmaxf(fabsf(p[F.lane]), fabsf(p[64 + F.lane])), F.lane); p = in_[6] + l * HD; const float gk = wave_max(fmaxf(fabsf(p[F.lane]), fabsf(p[64 + F.lane])), F.lane);
                  shiftA = 128.0f * gq * gk * 0.08838834764831845f * LOG2E - 15.0f; }
                for (int it = F.bid; it < 256; it += GRID) { const int h = it & 7, pr = it >> 3;
#pragma nounroll
                    for (int u2 = 0; u2 < 2; ++u2) attn_unit(F, BIG, ws + WS_VT, (const unsigned*)(ws + WS_MASK), h, u2 ? pr : 63 - pr, shiftA); }
                float shiftM;
                { int ln; asm volatile("v_mbcnt_lo_u32_b32 %0, -1, 0\n\tv_mbcnt_hi_u32_b32 %0, -1, %0" : "=v"(ln));
                  InPtrs in_ = KIN(); const float* p = in_[9] + l * MHD; const float gmq = wave_max(fmaxf(fmaxf(fabsf(p[ln]), fabsf(p[64 + ln])), fmaxf(fabsf(p[128 + ln]), fabsf(p[192 + ln]))), ln);
                  p = in_[10] + l * MHD; const float gmk = wave_max(fmaxf(fmaxf(fabsf(p[ln]), fabsf(p[64 + ln])), fmaxf(fabsf(p[128 + ln]), fabsf(p[192 + ln]))), ln);
                  shiftM = 256.0f * gmq * gmk * 0.0625f * LOG2E; }
                pg8::HeadSliceOrder S; S.init(SEQ, 1024, GRID, F.bid);
                pg8::Gemm g1{BIG + C_QM, (const bf16*)(ws + WS_MKN) + (size_t)b * 1024 * 256, SEQ, 1024, 256, LDB, 256};
                pg8::EpiMemP E1{XA, 1024, RSUM, shiftM};
                pg8::gemm_phase<pg8::EpiMemP, pg8::HeadSliceOrder, true>(glds, g1, S, E1, F.wave);
                pg8::Gemm g2{XA, (const bf16*)(ws + WS_MVT) + (size_t)b * 1024 * 256, SEQ, 1024, 256, 1024, 256};
                pg8::EpiMemO E2{(unsigned char*)BIG + 512 * (C_V >> 8) + 256, LDB * 2, RSUM, BR_ASC};
                pg8::gemm_phase<pg8::EpiMemO, pg8::HeadSliceOrder, true>(glds, g2, S, E2, F.wave);
            } PHASE_END
            PHASE_BEGIN if constexpr (EN(5)) {
                pg8::StaticOrder S; S.init(SEQ, DM, GRID, F.bid); const bf16* WBR = (const bf16*)(ws + WS_WBR);
                pg8::Gemm gc{BIG + C_CB, WBR, SEQ, DM, DM, LDB, DM}; pg8::EpiGate Ec{(const unsigned char*)(BIG + C_GC), LDB * 2, nullptr, XA, DM, 1.0f};
                pg8::gemm_phase<pg8::EpiGate, pg8::StaticOrder, true>(glds, gc, S, Ec, F.wave);
                const bf16* WBR8 = (const bf16*)(ws + WS_WBR8);
                pg8::Gemm ga{(const bf16*)((const unsigned char*)(BIG + C_K) + 128), WBR8, SEQ, DM, DM / 2, LDB, DM / 2, 256, 512}; pg8::EpiGate Ea{(const unsigned char*)(BIG + C_GA), LDB * 2, XA, XB, DM, 1.0f / (BR_ASC * BR_WSC)};
                pg8::gemm_phase<pg8::EpiGate, pg8::StaticOrder, true, true>(glds, ga, S, Ea, F.wave);
                pg8::Gemm gm{(const bf16*)((const unsigned char*)BIG + 512 * (C_V >> 8) + 256), WBR8 + (size_t)DM * DM / 2, SEQ, DM, DM / 2, LDB, DM / 2, 128, 512}; pg8::EpiGate Em{(const unsigned char*)(BIG + C_GM), LDB * 2, XB, XA, DM, 1.0f / (BR_ASC * BR_WSC)};
                pg8::gemm_phase<pg8::EpiGate, pg8::StaticOrder, true, true>(glds, gm, S, Em, F.wave);
            } PHASE_END
            PHASE_BEGIN if constexpr (EN(6)) {
                pg8::StaticOrder S; S.init(SEQ, DM, GRID, F.bid);
                pg8::Gemm g{XA, (const bf16*)(ws + WS_WOUT), SEQ, DM, DM, DM, DM};
                float one_ = 1.0f; asm volatile("" : "+s"(one_)); pg8::EpiResid E{xres + (size_t)b * SEQ * DM, outp + (size_t)b * SEQ * DM, DM, one_};
                pg8::gemm_phase<pg8::EpiResid, pg8::StaticOrder, true>(glds, g, S, E, F.wave);
                if (b == NBATCH - 1) phase_ffn_weights(F, KIN(), l);
            } PHASE_END
        }
        PHASE_BEGIN if constexpr (EN(7)) phase_ffn_norm(F, KIN(), outp, l); PHASE_END
        if ((l & 1) == 0) {
            PHASE_BEGIN if constexpr (EN(8)) {
                pg8::Gemm g{H2, (const bf16*)(ws + WS_WFF), TOK, 2 * DFF, DM / 2, DM / 2, DM / 2}; pg8::StaticOrder S; S.init(TOK, 2 * DFF, GRID, F.bid); float isc_ = 1.0f / MOE_WSC, hsc_ = MOE_HSC; asm volatile("" : "+s"(isc_), "+s"(hsc_)); pg8::EpiSwiGLU8 E{(unsigned char*)HID, DFF, isc_, hsc_};
                pg8::gemm_phase<pg8::EpiSwiGLU8, pg8::StaticOrder, true, true>(glds, g, S, E, F.wave);
            } PHASE_END
            PHASE_BEGIN if constexpr (EN(9)) {
                pg8::Gemm g{HID, (const bf16*)(ws + WS_WFF + WFF_DOWN), TOK, DM, DFF / 2, DFF / 2, DFF / 2}; pg8::StaticOrder S; S.init(TOK, DM, GRID, F.bid); float dsc_ = 1.0f / (MOE_WSC * MOE_HSC); asm volatile("" : "+s"(dsc_)); pg8::EpiResid E{outp, outp, DM, dsc_};
                pg8::gemm_phase<pg8::EpiResid, pg8::StaticOrder, true, true>(glds, g, S, E, F.wave);
            } PHASE_END
        } else {
            PHASE_BEGIN if constexpr (EN(10)) phase_moe_assign(F); PHASE_END
            for (int k = 0; k < 2; ++k) {
                const int* slotTok = (const int*)(ws + WS_TAB + TAB_SLOTTOK) + k * (MOE_MAXP * 256); const float* slotW = (const float*)(ws + WS_TAB + TAB_SLOTW) + k * (MOE_MAXP * 256);
                const int* pexp = (const int*)(ws + WS_TAB + TAB_PEXP) + k * 256; const int* npanp = (const int*)(ws + WS_TAB + TAB_NPAN) + k;
                PHASE_BEGIN if constexpr (EN(11)) {
                    int np = __builtin_amdgcn_readfirstlane(*npanp); np = np < 0 ? 0 : (np > MOE_MAXP ? MOE_MAXP : np);
                    if (k == 1) { int np0 = __builtin_amdgcn_readfirstlane(npanp[-1]); np0 = np0 > MOE_MAXP ? MOE_MAXP : np0;
                        if (np0 > 128) moe_tail_combine(F, (const float*)(ws + WS_END_FFN), slotTok - MOE_MAXP * 256, slotW - MOE_MAXP * 256, outp, np0); }
                    pg8::Gemm g{H2, (const bf16*)(ws + WS_WFF), np * 256, 2 * DFF, DM / 2, DM / 2, DM / 2};
                    pg8::MoeOrder<true> S; S.init(np * 256, 2 * DFF, GRID, F.bid); S.pexp = pexp; S.rowtok = slotTok; S.exp_stride = WFF_EXP / 2;
                    pg8::EpiSwiGLU8 E{(unsigned char*)HID, DFF, 1.0f / MOE_WSC, MOE_HSC};
                    pg8::gemm_phase<pg8::EpiSwiGLU8, pg8::MoeOrder<true>, true, true>(glds, g, S, E, F.wave);
                } PHASE_END
                PHASE_BEGIN if constexpr (EN(12)) {
                    int np = __builtin_amdgcn_readfirstlane(*npanp); np = np < 0 ? 0 : (np > MOE_MAXP ? MOE_MAXP : np);
                    const int npm = np < 128 ? np : 128;
                    pg8::Gemm g{HID, (const bf16*)(ws + WS_WFF + WFF_DOWN), npm * 256, DM, DFF / 2, DFF / 2, DFF / 2};
                    pg8::MoeOrder<false> S; S.init(npm * 256, DM, GRID, F.bid); S.pexp = pexp; S.rowtok = slotTok; S.exp_stride = WFF_EXP / 2;
                    pg8::EpiMoeDown E{slotTok, slotW, outp, DM, 1.0f / (MOE_WSC * MOE_HSC)};
                    pg8::gemm_phase<pg8::EpiMoeDown, pg8::MoeOrder<false>, true, true>(glds, g, S, E, F.wave);
                    if (np > 128) {
                        pg8::Gemm gt{HID, (const bf16*)(ws + WS_WFF + WFF_DOWN), np * 256, DM, MOE_KPART, DFF / 2, DFF / 2};
                        pg8::TailOrder St; St.nsub = (np - 128) * 4 * MOE_NSPLIT; St.c = F.bid; St.nsplit = MOE_NSPLIT; St.kpart = MOE_KPART; St.pexp = pexp; St.exp_stride = WFF_EXP / 2;
                        pg8::EpiPartF32 Et{(float*)(ws + WS_END_FFN) + (size_t)F.bid * 65536};
                        pg8::gemm_phase<pg8::EpiPartF32, pg8::TailOrder, true, true>(glds, gt, St, Et, F.wave);
                    }
                } PHASE_END
            }
            PHASE_BEGIN {
                const int* npanp = (const int*)(ws + WS_TAB + TAB_NPAN) + 1; int np1 = __builtin_amdgcn_readfirstlane(*npanp); np1 = np1 > MOE_MAXP ? MOE_MAXP : np1;
                if (np1 > 128) moe_tail_combine(F, (const float*)(ws + WS_END_FFN), (const int*)(ws + WS_TAB + TAB_SLOTTOK) + MOE_MAXP * 256, (const float*)(ws + WS_TAB + TAB_SLOTW) + MOE_MAXP * 256, outp, np1);
            } PHASE_END
        }
    }
#undef KIN
#undef PHASE_BEGIN
#undef PHASE_END
}

extern "C" void kernel_launch(void* const* d_in, const int* in_sizes, int n_in, void* d_out, int out_size, void* d_ws, size_t ws_size, hipStream_t stream) {
    static int ok = 0;
    if (ok == 0) {
        ok = -1;
        if (n_in != 23 || in_sizes[0] != TOK * DM || out_size != TOK * DM || ws_size < WS_NEED) { fprintf(stderr, "kernel_launch: unexpected shapes / workspace (n_in %d, ws %zu, need %zu)\n", n_in, ws_size, (size_t)WS_NEED); return; }
        int dev = 0, cus = 0, per_cu = 0;
        if (hipGetDevice(&dev) != hipSuccess || hipDeviceGetAttribute(&cus, hipDeviceAttributeMultiprocessorCount, dev) != hipSuccess) return;
        if (hipFuncSetAttribute((const void*)fwd_kernel, hipFuncAttributeMaxDynamicSharedMemorySize, LDS_BYTES) != hipSuccess) { fprintf(stderr, "kernel_launch: hipFuncSetAttribute failed\n"); return; }
        if (hipOccupancyMaxActiveBlocksPerMultiprocessor(&per_cu, (const void*)fwd_kernel, NTHREADS, LDS_BYTES) != hipSuccess || per_cu < 1) { fprintf(stderr, "kernel_launch: occupancy query says %d\n", per_cu); (void)hipGetLastError(); return; }
        if (cus < GRID) { fprintf(stderr, "kernel_launch: %d CUs < grid %d\n", cus, GRID); return; }
        ok = 1;
    }
    if (ok < 0) return;
    if (hipMemsetAsync((char*)d_ws + WS_CTL, 0, CTL_ZERO_BYTES, stream) != hipSuccess) return;
    Args a{};
    for (int i = 0; i < 23; ++i) a.in[i] = (const float*)d_in[i];
    a.out = (float*)d_out; a.ws = (unsigned char*)d_ws;
#if MK_N_LAUNCHES == 1
    a.ph_lo = 0; a.ph_hi = NPHASE;
    hipLaunchKernelGGL(fwd_kernel, dim3(GRID), dim3(NTHREADS), LDS_BYTES, stream, a);
#else
    for (int p = 0; p < NPHASE; ++p) { a.ph_lo = p; a.ph_hi = p + 1; hipLaunchKernelGGL(fwd_kernel, dim3(GRID), dim3(NTHREADS), LDS_BYTES, stream, a); }
#endif
}
```
